# Optimizing an MI355X kernel written in HIP

```python
import math
import jax, jax.numpy as jnp
from jax import lax
import numpy as np

D_MODEL = 2048
BATCH = 4
SEQ = 2048
DEPTH = 1
DEC_BATCH = 128
DEC_SEQ = 1
PAST_LEN = 16384
PAGE_SIZE = 128

N_META = 16
SSM_WIDTH = D_MODEL // 2
SSM_GROUP = 16
SSM_GROUPS = SSM_WIDTH // SSM_GROUP
SSM_STATE = 64
MLSTM_WIDTH = D_MODEL // 2
MLSTM_HEADS = 4
MLSTM_DK = MLSTM_WIDTH // MLSTM_HEADS
MLSTM_DV = MLSTM_WIDTH // MLSTM_HEADS
CHUNK = 128
D_FF = -(-8 * D_MODEL // (3 * 256)) * 256
EPS = 1e-5
ALPHA = (2 * DEPTH) ** 0.25
BETA = (8 * DEPTH) ** -0.25

N_IN = SSM_WIDTH + 2 * MLSTM_HEADS * MLSTM_DK + MLSTM_HEADS * MLSTM_DV + MLSTM_WIDTH + 2 * MLSTM_HEADS + 2 * D_MODEL
_SPLIT_SIZES = (SSM_WIDTH, MLSTM_HEADS * MLSTM_DK, MLSTM_HEADS * MLSTM_DK, MLSTM_HEADS * MLSTM_DV,
                MLSTM_WIDTH, 2 * MLSTM_HEADS, D_MODEL)
SPLITS = tuple(int(s) for s in np.cumsum(_SPLIT_SIZES))

kernel_name = "hybrid_s5_mlstm_gated_decoder_step"


def _layernorm(x, g, b):
    xf = x.astype(jnp.float32)
    mu = xf.mean(-1, keepdims=True)
    var = jnp.mean(jnp.square(xf - mu), -1, keepdims=True)
    return ((xf - mu) * lax.rsqrt(var + EPS) * g + b).astype(x.dtype)


def _ssm_combine(e1, e2):
    a1, b1 = e1
    a2, b2 = e2
    return a1 * a2, a2 * b1 + b2


def _s5_branch(u, h_re, h_im, a_re, a_im, log_dt, b_re, b_im, c_re, c_im, d_skip, w_glu, b_glu):
    bt, t, _ = u.shape
    f32 = jnp.float32
    lam = lax.complex(a_re.astype(f32), a_im.astype(f32))
    dt = jnp.exp(log_dt.astype(f32))
    a_bar = jnp.exp(lam * dt)
    b_bar = ((a_bar - 1.0) / lam)[..., None] * lax.complex(b_re.astype(f32), b_im.astype(f32))
    ug = u.reshape(bt, t, SSM_GROUPS, SSM_GROUP)
    bu = jnp.einsum("btgc,gpc->btgp", ug.astype(jnp.complex64), b_bar)
    h0 = lax.complex(h_re.astype(f32), h_im.astype(f32))
    bu = bu.at[:, 0].add(a_bar * h0)
    a_seq = jnp.broadcast_to(a_bar, bu.shape)
    _, hs = lax.associative_scan(_ssm_combine, (a_seq, bu), axis=1)
    c = lax.complex(c_re.astype(f32), c_im.astype(f32))
    y = jnp.einsum("btgp,gcp->btgc", hs, c).real + d_skip.astype(f32).reshape(SSM_GROUPS, SSM_GROUP) * ug
    y = y.reshape(bt, t, SSM_WIDTH)
    g = jax.nn.gelu(y)
    out = g * jax.nn.sigmoid(g @ w_glu.astype(f32) + b_glu.astype(f32))
    h_last = hs[:, -1]
    return out, h_last.real, h_last.imag


def _mlstm_chunk(state, q, k, v, ig, fl):
    c, n, m = state
    length = q.shape[2]
    b = jnp.cumsum(fl, axis=-1)
    causal = jnp.tril(jnp.ones((length, length), dtype=bool))
    dmat = jnp.where(causal, b[..., :, None] - b[..., None, :] + ig[..., None, :], -jnp.inf)
    inter = b + m[..., None]
    m_t = jnp.maximum(inter, dmat.max(-1))
    w_intra = jnp.exp(dmat - m_t[..., None])
    w_inter = jnp.exp(inter - m_t)
    s = jnp.einsum("bhtk,bhsk->bhts", q, k) * w_intra
    num = w_inter[..., None] * jnp.einsum("bhtk,bhkv->bhtv", q, c) + jnp.einsum("bhts,bhsv->bhtv", s, v)
    den = w_inter * jnp.einsum("bhtk,bhk->bht", q, n) + s.sum(-1)
    h = num / jnp.maximum(jnp.abs(den), jnp.exp(-m_t))[..., None]
    m_new = m_t[..., -1]
    w_end = jnp.exp(b[..., -1:] - b + ig - m_new[..., None])
    carry = jnp.exp(b[..., -1] + m - m_new)
    c_new = carry[..., None, None] * c + jnp.einsum("bhs,bhsk,bhsv->bhkv", w_end, k, v)
    n_new = carry[..., None] * n + jnp.einsum("bhs,bhsk->bhk", w_end, k)
    return (c_new, n_new, m_new), h


def _mlstm_branch(q, k, v, ig, fl, state, lead):
    state, h_lead = _mlstm_chunk(state, q[:, :, :lead], k[:, :, :lead], v[:, :, :lead],
                                 ig[:, :, :lead], fl[:, :, :lead])
    t = q.shape[2]
    if t == lead:
        return h_lead, state
    nc = (t - lead) // CHUNK

    def blocks(z):
        z = z[:, :, lead:]
        return jnp.moveaxis(z.reshape(z.shape[:2] + (nc, CHUNK) + z.shape[3:]), 2, 0)

    def step(carry, xs):
        return _mlstm_chunk(carry, *xs)

    state, h_rest = lax.scan(step, state, (blocks(q), blocks(k), blocks(v), blocks(ig), blocks(fl)))
    bsz, nh = q.shape[0], q.shape[1]
    h_rest = jnp.moveaxis(h_rest, 0, 2).reshape(bsz, nh, nc * CHUNK, MLSTM_DV)
    return jnp.concatenate([h_lead, h_rest], axis=2), state


def _layer(x, h_re, h_im, c0, n0, m0, lead, w_in, b_if, a_re, a_im, log_dt, b_re, b_im, c_re, c_im,
           d_skip, w_glu, b_glu, w_a_up, mh_gain, w_b_up, w_out, ln1_g, ln1_b, w_gate, w_up, w_down,
           ln2_g, ln2_b):
    f32 = jnp.float32
    bt, t, _ = x.shape
    proj = (x @ w_in).astype(f32)
    u, q, k, v, o, g_if, g_a, g_b = jnp.split(proj, SPLITS, axis=-1)
    y_a, h_re_new, h_im_new = _s5_branch(u, h_re, h_im, a_re, a_im, log_dt, b_re, b_im, c_re, c_im,
                                         d_skip, w_glu, b_glu)
    def heads(z):
        return z.reshape(bt, t, MLSTM_HEADS, -1).transpose(0, 2, 1, 3)
    g_if = g_if + b_if.astype(f32)
    ig = g_if[..., :MLSTM_HEADS].transpose(0, 2, 1)
    fl = jax.nn.log_sigmoid(g_if[..., MLSTM_HEADS:]).transpose(0, 2, 1)
    state0 = (c0.astype(f32), n0.astype(f32), m0.astype(f32))
    h, (c_new, n_new, m_new) = _mlstm_branch(heads(q), heads(k) * (MLSTM_DK ** -0.5), heads(v), ig, fl,
                                             state0, lead)
    mu = h.mean(-1, keepdims=True)
    var = jnp.mean(jnp.square(h - mu), -1, keepdims=True)
    hn = ((h - mu) * lax.rsqrt(var + EPS)).transpose(0, 2, 1, 3).reshape(bt, t, MLSTM_WIDTH)
    y_b = jax.nn.sigmoid(o) * (hn * mh_gain.astype(f32))
    mix = jax.nn.sigmoid(g_a) * (y_a @ w_a_up.astype(f32)) + jax.nn.sigmoid(g_b) * (y_b @ w_b_up.astype(f32))
    mix = (mix @ w_out.astype(f32)).astype(x.dtype)
    x = _layernorm(ALPHA * x + mix, ln1_g, ln1_b)
    ff = (jax.nn.silu(x @ w_gate) * (x @ w_up)) @ w_down
    x = _layernorm(ALPHA * x + ff.astype(x.dtype), ln2_g, ln2_b)
    return x, (h_re_new, h_im_new, c_new, n_new, m_new)


def setup_inputs(seed: int = 0) -> dict:
    key = jax.random.key(seed)
    ks = jax.random.split(key, 32)
    f32 = jnp.float32

    def nrm(k, shape, s):
        return s * jax.random.normal(k, shape, f32)

    G, P, H = SSM_GROUPS, SSM_STATE, MLSTM_HEADS
    b_if = jnp.concatenate([
        nrm(ks[10], (DEPTH, H), 0.1),
        jnp.broadcast_to(jnp.linspace(3.0, 6.0, H, dtype=f32), (DEPTH, H)) + nrm(ks[11], (DEPTH, H), 0.1)],
        axis=-1)
    return {
        "x_prompt": nrm(ks[0], (BATCH, SEQ, D_MODEL), 1.0),
        "x_sample": nrm(ks[1], (DEC_BATCH, DEC_SEQ, D_MODEL), 1.0),
        "state_ssm_re": nrm(ks[2], (DEPTH, DEC_BATCH, G, P), 1.0),
        "state_ssm_im": nrm(ks[3], (DEPTH, DEC_BATCH, G, P), 1.0),
        "state_mlstm_c": nrm(ks[4], (DEPTH, DEC_BATCH, H, MLSTM_DK, MLSTM_DV), 0.1),
        "state_mlstm_n": nrm(ks[5], (DEPTH, DEC_BATCH, H, MLSTM_DK), 0.1),
        "state_mlstm_m": nrm(ks[6], (DEPTH, DEC_BATCH, H), 1.0),
        "meta_tokens": nrm(ks[7], (N_META, D_MODEL), 1.0),
        "w_in": nrm(ks[8], (DEPTH, D_MODEL, N_IN), D_MODEL ** -0.5),
        "b_if": b_if,
        "ssm_a_re": -0.5 + nrm(ks[12], (DEPTH, G, P), 0.01),
        "ssm_a_im": jnp.pi * jnp.arange(P, dtype=f32) + nrm(ks[13], (DEPTH, G, P), 0.01),
        "ssm_log_dt": jax.random.uniform(ks[14], (DEPTH, G, P), f32, math.log(1e-3), math.log(1e-1)),
        "ssm_b_re": nrm(ks[15], (DEPTH, G, P, SSM_GROUP), (2 * SSM_GROUP) ** -0.5),
        "ssm_b_im": nrm(ks[16], (DEPTH, G, P, SSM_GROUP), (2 * SSM_GROUP) ** -0.5),
        "ssm_c_re": nrm(ks[17], (DEPTH, G, SSM_GROUP, P), (2 * P) ** -0.5),
        "ssm_c_im": nrm(ks[18], (DEPTH, G, SSM_GROUP, P), (2 * P) ** -0.5),
        "ssm_d": nrm(ks[19], (DEPTH, SSM_WIDTH), 1.0),
        "w_glu": nrm(ks[20], (DEPTH, SSM_WIDTH, SSM_WIDTH), SSM_WIDTH ** -0.5),
        "b_glu": nrm(ks[21], (DEPTH, SSM_WIDTH), 0.01),
        "w_a_up": nrm(ks[22], (DEPTH, SSM_WIDTH, D_MODEL), SSM_WIDTH ** -0.5),
        "mh_gain": 1.0 + nrm(ks[23], (DEPTH, MLSTM_WIDTH), 0.01),
        "w_b_up": nrm(ks[24], (DEPTH, MLSTM_WIDTH, D_MODEL), MLSTM_WIDTH ** -0.5),
        "w_out": nrm(ks[25], (DEPTH, D_MODEL, D_MODEL), BETA * D_MODEL ** -0.5),
        "ln1_g": 1.0 + nrm(ks[26], (DEPTH, D_MODEL), 0.01),
        "ln1_b": nrm(ks[27], (DEPTH, D_MODEL), 0.01),
        "w_gate": nrm(ks[28], (DEPTH, D_MODEL, D_FF), D_MODEL ** -0.5),
        "w_up": nrm(ks[29], (DEPTH, D_MODEL, D_FF), D_MODEL ** -0.5),
        "w_down": nrm(ks[30], (DEPTH, D_FF, D_MODEL), BETA * D_FF ** -0.5),
        "ln2_g": 1.0 + nrm(ks[31], (DEPTH, D_MODEL), 0.01),
        "ln2_b": nrm(ks[9], (DEPTH, D_MODEL), 0.01),
    }


def reference(x_prompt, x_sample, state_ssm_re, state_ssm_im, state_mlstm_c, state_mlstm_n, state_mlstm_m,
              meta_tokens, w_in, b_if, ssm_a_re, ssm_a_im, ssm_log_dt, ssm_b_re, ssm_b_im, ssm_c_re, ssm_c_im,
              ssm_d, w_glu, b_glu, w_a_up, mh_gain, w_b_up, w_out, ln1_g, ln1_b, w_gate, w_up, w_down,
              ln2_g, ln2_b):
    f32 = jnp.float32
    bp = x_prompt.shape[0]
    meta = jnp.broadcast_to(meta_tokens.astype(x_prompt.dtype)[None], (bp, N_META, D_MODEL))
    xp = jnp.concatenate([meta, x_prompt], axis=1)
    xs = x_sample
    new_p = ([], [], [], [], [])
    new_s = ([], [], [], [], [])
    for l in range(DEPTH):
        lw = (w_in[l], b_if[l], ssm_a_re[l], ssm_a_im[l], ssm_log_dt[l], ssm_b_re[l], ssm_b_im[l],
              ssm_c_re[l], ssm_c_im[l], ssm_d[l], w_glu[l], b_glu[l], w_a_up[l], mh_gain[l], w_b_up[l],
              w_out[l], ln1_g[l], ln1_b[l], w_gate[l], w_up[l], w_down[l], ln2_g[l], ln2_b[l])
        z_ssm = jnp.zeros((bp, SSM_GROUPS, SSM_STATE), f32)
        z_c = jnp.zeros((bp, MLSTM_HEADS, MLSTM_DK, MLSTM_DV), f32)
        z_n = jnp.zeros((bp, MLSTM_HEADS, MLSTM_DK), f32)
        z_m = jnp.zeros((bp, MLSTM_HEADS), f32)
        xp, st_p = _layer(xp, z_ssm, z_ssm, z_c, z_n, z_m, N_META, *lw)
        xs, st_s = _layer(xs, state_ssm_re[l], state_ssm_im[l], state_mlstm_c[l], state_mlstm_n[l],
                          state_mlstm_m[l], xs.shape[1], *lw)
        for lst, a in zip(new_p, st_p):
            lst.append(a)
        for lst, a in zip(new_s, st_s):
            lst.append(a)
    y_prompt = xp[:, N_META:]
    y_sample = xs
    p_ssm_re = jnp.stack(new_p[0])
    p_ssm_im = jnp.stack(new_p[1])
    p_mlstm_c = jnp.stack(new_p[2])
    p_mlstm_n = jnp.stack(new_p[3])
    p_mlstm_m = jnp.stack(new_p[4])
    s_ssm_re = jnp.stack(new_s[0])
    s_ssm_im = jnp.stack(new_s[1])
    s_mlstm_c = jnp.stack(new_s[2])
    s_mlstm_n = jnp.stack(new_s[3])
    s_mlstm_m = jnp.stack(new_s[4])
    return (y_prompt, y_sample, p_ssm_re, p_ssm_im, p_mlstm_c, p_mlstm_n, p_mlstm_m,
            s_ssm_re, s_ssm_im, s_mlstm_c, s_mlstm_n, s_mlstm_m)
```

```cpp
#include <hip/hip_runtime.h>
#include <hip/hip_cooperative_groups.h>
#include <cstdio>
namespace cg = cooperative_groups;


#ifndef GREP1
#define GREP1 1
#endif
#ifndef GREP10
#define GREP10 1
#endif
#ifndef ONE_LAUNCH
#define ONE_LAUNCH 1
#endif

typedef unsigned short bf16_t;
typedef short bf16x8 __attribute__((ext_vector_type(8)));
typedef float f32x4 __attribute__((ext_vector_type(4)));
typedef float f32x2 __attribute__((ext_vector_type(2)));
typedef unsigned u32x4 __attribute__((ext_vector_type(4)));
typedef unsigned u32x2 __attribute__((ext_vector_type(2)));
#define LAS __attribute__((address_space(3)))

constexpr int D = 2048, MP = 8448, ROW_S = 8192, ROW_META = 8320, NREAL = 8320;
constexpr int NPROJ = 9216, DFF = 5632;
constexpr int C_U = 0, C_Q = 1024, C_K = 2048, C_V = 3072, C_O = 4096, C_GA = 5120, C_GB = 7168;
constexpr float EPS = 1e-5f;
constexpr float ALPHA = 1.189207115002721f;
constexpr int LDS_BYTES = 155648;
constexpr int SM_OFF = 139264;
constexpr int BARST_OFF = SM_OFF + 16000;

constexpr size_t O_XB = 0;
constexpr size_t O_WINT = O_XB + 34603008;
constexpr size_t O_GIF = O_WINT + 37748736;
constexpr size_t O_PROJ = O_GIF + 270336;
constexpr size_t O_WGLUT = O_PROJ + 155713536;
constexpr size_t O_WAT = O_WGLUT + 2097152;
constexpr size_t O_WBT = O_WAT + 4194304;
constexpr size_t O_WOUTT = O_WBT + 4194304;
constexpr size_t O_WGUT = O_WOUTT + 8388608;
constexpr size_t O_WDT = O_WGUT + 46137344;
constexpr size_t O_YB = O_WDT + 23068672;
constexpr size_t O_TMP = O_YB + 17301504;
constexpr size_t O_MIX = O_TMP + 69206016;
constexpr size_t O_R = O_MIX + 34603008;
constexpr size_t O_NLOC = O_R + 71303168;
constexpr size_t O_NJ = O_NLOC + 278528;
constexpr size_t O_GST = O_NJ + 278528;
constexpr size_t O_ESSM = O_GST + 4096;
constexpr size_t O_BAR = O_ESSM + 2129920;
constexpr size_t O_END = O_BAR + 16384;
constexpr size_t O_G = O_WINT, O_YA = O_WINT + 17301504, O_X1B = O_XB, O_HFF = O_PROJ, O_X1 = O_TMP, O_CTB = O_MIX, O_LOCT = O_R;

struct Params { const float* in[31]; float* out; unsigned char* ws; int ph_lo, ph_hi; };

constexpr size_t OUT_YP = 0, OUT_YS = 16777216, OUT_PRE = OUT_YS + 262144, OUT_PIM = OUT_PRE + 16384, OUT_PC = OUT_PIM + 16384,
                 OUT_PN = OUT_PC + 1048576, OUT_PM = OUT_PN + 4096, OUT_SRE = OUT_PM + 16, OUT_SIM = OUT_SRE + 524288, OUT_SC = OUT_SIM + 524288,
                 OUT_SN = OUT_SC + 33554432, OUT_SM = OUT_SN + 131072, OUT_END = OUT_SM + 512;

__device__ __forceinline__ unsigned cvt_pk_bf16(float lo, float hi) { unsigned r; asm volatile("v_cvt_pk_bf16_f32 %0, %1, %2" : "=v"(r) : "v"(lo), "v"(hi)); return r; }
__device__ __forceinline__ bf16_t f2bf(float f) { unsigned u = __float_as_uint(f); u += 0x7FFFu + ((u >> 16) & 1u); return (bf16_t)(u >> 16); }
__device__ __forceinline__ float bf2f(bf16_t b) { return __uint_as_float(((unsigned)b) << 16); }
__device__ __forceinline__ float bflo(unsigned w) { return __uint_as_float(w << 16); }
__device__ __forceinline__ float bfhi(unsigned w) { return __uint_as_float(w & 0xffff0000u); }
__device__ __forceinline__ float sigmoidf_(float x) { return __builtin_amdgcn_rcpf(1.0f + __expf(-x)); }
__device__ __forceinline__ float logsig(float x) { return fminf(x, 0.f) - log1pf(__expf(-fabsf(x))); }
__device__ __forceinline__ float gelu_tanh(float x) { const float z = 1.5957691216057308f * (x + 0.044715f * x * x * x); return x * sigmoidf_(z); }
template <int CTRL> __device__ __forceinline__ float dpp_mov(float x) { return __builtin_bit_cast(float, __builtin_amdgcn_update_dpp(0, __builtin_bit_cast(int, x), CTRL, 0xf, 0xf, false)); }
__device__ __forceinline__ float row16_sum(float x) { x += dpp_mov<0x128>(x); x += dpp_mov<0x124>(x); x += dpp_mov<0x122>(x); x += dpp_mov<0x121>(x); return x; }
__device__ __forceinline__ float row16_max(float x) { x = fmaxf(x, dpp_mov<0x128>(x)); x = fmaxf(x, dpp_mov<0x124>(x)); x = fmaxf(x, dpp_mov<0x122>(x)); x = fmaxf(x, dpp_mov<0x121>(x)); return x; }
__device__ __forceinline__ float lane_bcast(float x, int l) { return __builtin_bit_cast(float, __builtin_amdgcn_readlane(__builtin_bit_cast(int, x), l)); }
__device__ __forceinline__ float wave_sum(float v) { v = row16_sum(v); return (lane_bcast(v, 0) + lane_bcast(v, 16)) + (lane_bcast(v, 32) + lane_bcast(v, 48)); }
__device__ __forceinline__ float wave_max(float v) { v = row16_max(v); return fmaxf(fmaxf(lane_bcast(v, 0), lane_bcast(v, 16)), fmaxf(lane_bcast(v, 32), lane_bcast(v, 48))); }
__device__ __forceinline__ float wave_incl_scan(float v, int lane) {
#pragma unroll
    for (int o = 1; o < 64; o <<= 1) { const float t = __shfl_up(v, o); if (lane >= o) v += t; } return v; }
__device__ __forceinline__ float block_sum(float v, float* scratch) {
    v = wave_sum(v); if ((threadIdx.x & 63) == 0) scratch[threadIdx.x >> 6] = v; __syncthreads();
    float r = 0.f;
#pragma unroll
    for (int w = 0; w < 8; ++w) r += scratch[w];
    __syncthreads(); return r; }
__device__ __forceinline__ f32x4 mfma16(bf16x8 a, bf16x8 b, f32x4 c) { return __builtin_amdgcn_mfma_f32_16x16x32_bf16(a, b, c, 0, 0, 0); }
#define MFMA_SETTLE() do { __builtin_amdgcn_sched_barrier(0); asm volatile("s_nop 15\n\ts_nop 15" ::: "memory"); __builtin_amdgcn_sched_barrier(0); } while (0)

namespace pg8 {
constexpr int BM = 256, BK = 64, HALF = 128, HTB = HALF * BK * 2, STAGE_BYTES = 8 * HTB, NXCD = 8, WGM = 8;
__host__ __device__ __forceinline__ int lds_byte(int r, int c) { const int st = (r >> 4) * 2 + (c >> 5), rr = r & 15, cc = c & 31, ob = rr * 64 + cc * 2; return st * 1024 + (ob ^ (((ob >> 9) & 1) << 5)); }
__host__ __device__ __forceinline__ void stage_rc(int b, int& R, int& C) { const int st = b / 1024, sb = b % 1024, swz = sb ^ (((sb >> 9) & 1) << 5); R = (st >> 1) * 16 + swz / 64; C = (st & 1) * 32 + (swz % 64) / 2; }
__host__ __device__ __forceinline__ int perm32(int rho) { const int n = rho >> 4, i = rho & 15; return 8 * (i >> 2) + 4 * n + (i & 3); }
struct Unit { int pm, pn; };
struct Gemm { const bf16_t* A; const bf16_t* Bt; int M, N, K; };
struct StaticOrder {
    int nM, nN, nwg, G, c, rep;
    __device__ void init(int M, int N, int G_, int c_, int rep_ = 1) { nM = M / BM; nN = N / BM; nwg = nM * nN; G = G_; c = c_; rep = rep_; }
    __device__ bool next(int i, Unit& u) const {
        long L = (long)i * G + c; if (L >= (long)nwg * rep) return false;
        L %= nwg;
        int wgid = (int)L; { const int q = nwg / NXCD, r = nwg % NXCD, xcd = wgid % NXCD, off = wgid / NXCD; wgid = (xcd < r ? xcd * (q + 1) : r * (q + 1) + (xcd - r) * q) + off; }
        const int nig = WGM * nN, gid = wgid / nig, fm = gid * WGM, gsz = (nM - fm) < WGM ? (nM - fm) : WGM;
        u.pm = fm + ((wgid % nig) % gsz); u.pn = (wgid % nig) / gsz; return true;
    }
};

template <class Epi>
__device__ __forceinline__ void gemm_phase(LAS unsigned char* lds, const Gemm g, const StaticOrder& S, const Epi& E) {
    const int tid = threadIdx.x, wid = __builtin_amdgcn_readfirstlane(tid >> 6), lane = tid & 63, wr = wid >> 2, wc = wid & 3, fr = lane & 15, fq = lane >> 4;
    const int K = g.K, nt = K / BK;
    unsigned voffA[2], voffB[2];
#pragma unroll
    for (int i = 0; i < 2; ++i) { int R, C; stage_rc(tid * 16 + i * 8192, R, C); const int Rb = Epi::PERM ? ((R & ~31) + perm32(R & 31)) : R;
        voffA[i] = (unsigned)(R * K + C) * 2u; voffB[i] = (unsigned)(Rb * K + C) * 2u; }
    const size_t kstep = (size_t)(BK * 2);
    const size_t hstep = (size_t)HALF * K * 2;
    const size_t tstep = 2 * hstep;
    const unsigned ldsw = (unsigned)wid * 1024u;
    const int aoff = lds_byte(wr * 64 + fr, fq * 8), boff = lds_byte(wc * 32 + fr, fq * 8);
#define PG8_SA(b, h) (((b) * 2 + (h)) * HTB)
#define PG8_SB(b, h) ((4 + (b) * 2 + (h)) * HTB)
#define PG8_STAGE(bufoff, gbase, voff) do { _Pragma("unroll") for (int _i = 0; _i < 2; ++_i) \
        __builtin_amdgcn_global_load_lds((const unsigned*)((const char*)(gbase) + (voff)[_i]), (LAS unsigned*)(lds + (bufoff) + ldsw + _i * 8192), 16, 0, 0); } while (0)
#define PG8_LDA(dst, b, h) do { _Pragma("unroll") for (int m = 0; m < 4; ++m) _Pragma("unroll") for (int k = 0; k < 2; ++k) dst[m][k] = *(const LAS bf16x8*)(lds + PG8_SA(b, h) + aoff + m * 2048 + k * 1024); } while (0)
#define PG8_LDB(dst, b, h) do { _Pragma("unroll") for (int n = 0; n < 2; ++n) _Pragma("unroll") for (int k = 0; k < 2; ++k) dst[n][k] = *(const LAS bf16x8*)(lds + PG8_SB(b, h) + boff + n * 2048 + k * 1024); } while (0)
#define PG8_MMA(ai, bj, At, Bt) do { __builtin_amdgcn_s_setprio(1); _Pragma("unroll") for (int m = 0; m < 4; ++m) _Pragma("unroll") for (int n = 0; n < 2; ++n) _Pragma("unroll") for (int k = 0; k < 2; ++k) \
        acc[ai][bj][m][n] = __builtin_amdgcn_mfma_f32_16x16x32_bf16(Bt[n][k], At[m][k], acc[ai][bj][m][n], 0, 0, 0); __builtin_amdgcn_s_setprio(0); } while (0)
#define PG8_WAIT_V(n) asm volatile("s_waitcnt vmcnt(" #n ")" ::: "memory")
#define PG8_WAIT_L(n) asm volatile("s_waitcnt lgkmcnt(" #n ")" ::: "memory")
#define PG8_BAR __builtin_amdgcn_s_barrier()
#define PG8_SCHED __builtin_amdgcn_sched_barrier(0)
    Unit cur, nxt; int ui = 0;
    if (!S.next(0, cur)) return;
    f32x4 acc[2][2][4][2];
#pragma unroll
    for (int a = 0; a < 2; ++a)
#pragma unroll
        for (int b = 0; b < 2; ++b)
#pragma unroll
            for (int m = 0; m < 4; ++m)
#pragma unroll
                for (int n = 0; n < 2; ++n) acc[a][b][m][n] = (f32x4){0.f, 0.f, 0.f, 0.f};
    bf16x8 At[4][2], B0[2][2], B1[2][2];
    const char* cA = (const char*)g.A + (size_t)cur.pm * tstep; const char* cB = (const char*)g.Bt + (size_t)cur.pn * tstep;
    PG8_STAGE(PG8_SB(0, 0), cB, voffB); PG8_STAGE(PG8_SA(0, 0), cA, voffA); PG8_STAGE(PG8_SB(0, 1), cB + hstep, voffB); PG8_STAGE(PG8_SA(0, 1), cA + hstep, voffA);
    if (wr == 1) PG8_BAR;
    PG8_WAIT_V(4); PG8_BAR;
    PG8_STAGE(PG8_SB(1, 0), cB + kstep, voffB); PG8_STAGE(PG8_SA(1, 0), cA + kstep, voffA); PG8_STAGE(PG8_SB(1, 1), cB + hstep + kstep, voffB);
    PG8_WAIT_V(6); PG8_BAR;
    for (;;) {
        const bool has_next = S.next(ui + 1, nxt);
        const char* nA = has_next ? (const char*)g.A + (size_t)nxt.pm * tstep : cA; const char* nB = has_next ? (const char*)g.Bt + (size_t)nxt.pn * tstep : cB;
        for (int t = 0; t < nt; t += 2) {
            const bool last = (t == nt - 2);
            const char* a1 = cA + (size_t)(t + 1) * kstep;
            const char* a2 = last ? nA : cA + (size_t)(t + 2) * kstep; const char* b2 = last ? nB : cB + (size_t)(t + 2) * kstep;
            const char* a3 = a2 + kstep; const char* b3 = b2 + kstep;
            PG8_LDB(B0, 0, 0); PG8_SCHED; PG8_LDA(At, 0, 0); PG8_STAGE(PG8_SA(1, 1), a1 + hstep, voffA);
            PG8_WAIT_L(8); PG8_BAR; PG8_WAIT_L(0); PG8_MMA(0, 0, At, B0); PG8_BAR; PG8_SCHED;
            PG8_LDB(B1, 0, 1); PG8_STAGE(PG8_SB(0, 0), b2, voffB);
            PG8_BAR; PG8_WAIT_L(0); PG8_MMA(0, 1, At, B1); PG8_BAR;
            PG8_LDA(At, 0, 1); PG8_STAGE(PG8_SA(0, 0), a2, voffA);
            PG8_BAR; PG8_WAIT_L(0); PG8_MMA(1, 0, At, B0); PG8_BAR; PG8_SCHED;
            PG8_STAGE(PG8_SB(0, 1), b2 + hstep, voffB);
            PG8_WAIT_V(6); PG8_BAR; PG8_MMA(1, 1, At, B1); PG8_BAR;
            PG8_LDB(B0, 1, 0); PG8_SCHED; PG8_LDA(At, 1, 0); PG8_STAGE(PG8_SA(0, 1), a2 + hstep, voffA);
            PG8_WAIT_L(8); PG8_BAR; PG8_WAIT_L(0); PG8_MMA(0, 0, At, B0); PG8_BAR; PG8_SCHED;
            PG8_LDB(B1, 1, 1); PG8_STAGE(PG8_SB(1, 0), b3, voffB);
            PG8_BAR; PG8_WAIT_L(0); PG8_MMA(0, 1, At, B1); PG8_BAR;
            PG8_LDA(At, 1, 1); PG8_STAGE(PG8_SA(1, 0), a3, voffA);
            PG8_BAR; PG8_WAIT_L(0); PG8_MMA(1, 0, At, B0); PG8_BAR; PG8_SCHED;
            PG8_STAGE(PG8_SB(1, 1), b3 + hstep, voffB);
            PG8_WAIT_V(6); PG8_BAR; PG8_MMA(1, 1, At, B1); PG8_BAR;
        }
        E(acc, cur, wr, wc, fr, fq);
        if (!has_next) break;
#pragma unroll
        for (int a = 0; a < 2; ++a)
#pragma unroll
            for (int b = 0; b < 2; ++b)
#pragma unroll
                for (int m = 0; m < 4; ++m)
#pragma unroll
                    for (int n = 0; n < 2; ++n) acc[a][b][m][n] = (f32x4){0.f, 0.f, 0.f, 0.f};
        cur = nxt; cA = nA; cB = nB; ++ui;
    }
    PG8_WAIT_V(0);
    if (wr == 0) PG8_BAR;
    PG8_BAR;
#undef PG8_SA
#undef PG8_SB
#undef PG8_STAGE
#undef PG8_LDA
#undef PG8_LDB
#undef PG8_MMA
#undef PG8_WAIT_V
#undef PG8_WAIT_L
#undef PG8_BAR
#undef PG8_SCHED
}
}

typedef f32x4 AccT[2][2][4][2];
#define EPI_LOOP_ROWS for (int ai = 0; ai < 2; ++ai) for (int m = 0; m < 4; ++m)
__device__ __forceinline__ u32x4 pack8(const f32x4 v0, const f32x4 v1) { u32x4 w; w.x = cvt_pk_bf16(v0[0], v0[1]); w.y = cvt_pk_bf16(v0[2], v0[3]); w.z = cvt_pk_bf16(v1[0], v1[1]); w.w = cvt_pk_bf16(v1[2], v1[3]); return w; }
__device__ __forceinline__ void unpack8(const u32x4 w, f32x4& v0, f32x4& v1) { v0 = (f32x4){bflo(w.x), bfhi(w.x), bflo(w.y), bfhi(w.y)}; v1 = (f32x4){bflo(w.z), bfhi(w.z), bflo(w.w), bfhi(w.w)}; }
__device__ __forceinline__ f32x4 sig4(const f32x4 v) { return (f32x4){sigmoidf_(v[0]), sigmoidf_(v[1]), sigmoidf_(v[2]), sigmoidf_(v[3])}; }

struct EpiIn {
    static constexpr bool PERM = true; bf16_t* O;
    __device__ __forceinline__ void operator()(const AccT& acc, const pg8::Unit& u, int wr, int wc, int fr, int fq) const {
        const int row0 = u.pm * 256 + wr * 64 + fr, col0 = u.pn * 256 + wc * 32 + 8 * fq;
#pragma unroll
        for (int ai = 0; ai < 2; ++ai)
#pragma unroll
            for (int m = 0; m < 4; ++m) { bf16_t* rowp = O + (size_t)(row0 + ai * 128 + m * 16) * NPROJ + col0;
#pragma unroll
                for (int bj = 0; bj < 2; ++bj) *(u32x4*)(rowp + bj * 128) = pack8(acc[ai][bj][m][0], acc[ai][bj][m][1]); }
    }
};
struct EpiGlu {
    static constexpr bool PERM = true; const bf16_t* G; bf16_t* O; const float* bias;
    __device__ __forceinline__ void operator()(const AccT& acc, const pg8::Unit& u, int wr, int wc, int fr, int fq) const {
        const int row0 = u.pm * 256 + wr * 64 + fr, col0 = u.pn * 256 + wc * 32 + 8 * fq;
        f32x4 bv[2][2];
#pragma unroll
        for (int bj = 0; bj < 2; ++bj)
#pragma unroll
            for (int n = 0; n < 2; ++n) bv[bj][n] = *(const f32x4*)(bias + col0 + bj * 128 + 4 * n);
#pragma unroll
        for (int ai = 0; ai < 2; ++ai) { u32x4 gw[4][2];
#pragma unroll
            for (int m = 0; m < 4; ++m)
#pragma unroll
                for (int bj = 0; bj < 2; ++bj) gw[m][bj] = *(const u32x4*)(G + (size_t)(row0 + ai * 128 + m * 16) * 1024 + col0 + bj * 128);
#pragma unroll
            for (int m = 0; m < 4; ++m)
#pragma unroll
                for (int bj = 0; bj < 2; ++bj) { f32x4 g0, g1; unpack8(gw[m][bj], g0, g1);
                    *(u32x4*)(O + (size_t)(row0 + ai * 128 + m * 16) * 1024 + col0 + bj * 128) = pack8(g0 * sig4(acc[ai][bj][m][0] + bv[bj][0]), g1 * sig4(acc[ai][bj][m][1] + bv[bj][1])); } }
    }
};
struct EpiUpA {
    static constexpr bool PERM = true; const bf16_t* PROJ; bf16_t* T;
    __device__ __forceinline__ void operator()(const AccT& acc, const pg8::Unit& u, int wr, int wc, int fr, int fq) const {
        const int row0 = u.pm * 256 + wr * 64 + fr, col0 = u.pn * 256 + wc * 32 + 8 * fq;
#pragma unroll
        for (int ai = 0; ai < 2; ++ai) { u32x4 gw[4][2];
#pragma unroll
            for (int m = 0; m < 4; ++m)
#pragma unroll
                for (int bj = 0; bj < 2; ++bj) gw[m][bj] = *(const u32x4*)(PROJ + (size_t)(row0 + ai * 128 + m * 16) * NPROJ + C_GA + col0 + bj * 128);
#pragma unroll
            for (int m = 0; m < 4; ++m)
#pragma unroll
                for (int bj = 0; bj < 2; ++bj) { f32x4 g0, g1; unpack8(gw[m][bj], g0, g1);
                    *(u32x4*)(T + (size_t)(row0 + ai * 128 + m * 16) * D + col0 + bj * 128) = pack8(sig4(g0) * acc[ai][bj][m][0], sig4(g1) * acc[ai][bj][m][1]); } }
    }
};
struct EpiUpB {
    static constexpr bool PERM = true; const bf16_t* PROJ; const bf16_t* T; bf16_t* O;
    __device__ __forceinline__ void operator()(const AccT& acc, const pg8::Unit& u, int wr, int wc, int fr, int fq) const {
        const int row0 = u.pm * 256 + wr * 64 + fr, col0 = u.pn * 256 + wc * 32 + 8 * fq;
#pragma unroll
        for (int ai = 0; ai < 2; ++ai) { u32x4 gw[4][2], tw[4][2];
#pragma unroll
            for (int m = 0; m < 4; ++m)
#pragma unroll
                for (int bj = 0; bj < 2; ++bj) { const int r = row0 + ai * 128 + m * 16; gw[m][bj] = *(const u32x4*)(PROJ + (size_t)r * NPROJ + C_GB + col0 + bj * 128); tw[m][bj] = *(const u32x4*)(T + (size_t)r * D + col0 + bj * 128); }
#pragma unroll
            for (int m = 0; m < 4; ++m)
#pragma unroll
                for (int bj = 0; bj < 2; ++bj) { f32x4 g0, g1, t0, t1; unpack8(gw[m][bj], g0, g1); unpack8(tw[m][bj], t0, t1);
                    *(u32x4*)(O + (size_t)(row0 + ai * 128 + m * 16) * D + col0 + bj * 128) = pack8(t0 + sig4(g0) * acc[ai][bj][m][0], t1 + sig4(g1) * acc[ai][bj][m][1]); } }
    }
};
struct EpiRes {
    static constexpr bool PERM = true; const float* xp; const float* xs; const bf16_t* X1; int mode; bf16_t* R;
    __device__ __forceinline__ void operator()(const AccT& acc, const pg8::Unit& u, int wr, int wc, int fr, int fq) const {
        const int row0 = u.pm * 256 + wr * 64 + fr, col0 = u.pn * 256 + wc * 32 + 8 * fq;
#pragma unroll
        for (int ai = 0; ai < 2; ++ai) { f32x4 b0[4][2], b1[4][2];
#pragma unroll
            for (int m = 0; m < 4; ++m) { const int r = row0 + ai * 128 + m * 16; const int rc = r < NREAL ? r : NREAL - 1;
#pragma unroll
                for (int bj = 0; bj < 2; ++bj) {
                    if (mode) unpack8(*(const u32x4*)(X1 + (size_t)rc * D + col0 + bj * 128), b0[m][bj], b1[m][bj]);
                    else { const float* b2 = (rc < ROW_S ? xp + (size_t)rc * D : xs + (size_t)(rc - ROW_S) * D) + col0 + bj * 128; b0[m][bj] = *(const f32x4*)b2; b1[m][bj] = *(const f32x4*)(b2 + 4); } } }
#pragma unroll
            for (int m = 0; m < 4; ++m) { const int r = row0 + ai * 128 + m * 16;
                if (r < NREAL) {
#pragma unroll
                    for (int bj = 0; bj < 2; ++bj) *(u32x4*)(R + (size_t)r * D + col0 + bj * 128) = pack8(ALPHA * b0[m][bj] + acc[ai][bj][m][0], ALPHA * b1[m][bj] + acc[ai][bj][m][1]); } } }
    }
};
struct EpiGU {
    static constexpr bool PERM = true; bf16_t* O;
    __device__ __forceinline__ void operator()(const AccT& acc, const pg8::Unit& u, int wr, int wc, int fr, int fq) const {
        const int row0 = u.pm * 256 + wr * 64 + fr, col0 = u.pn * 128 + wc * 32 + 8 * fq;
#pragma unroll
        for (int ai = 0; ai < 2; ++ai)
#pragma unroll
            for (int m = 0; m < 4; ++m) { const int r = row0 + ai * 128 + m * 16;
                const f32x4 g0 = acc[ai][0][m][0], g1 = acc[ai][0][m][1];
                const f32x4 o0 = g0 * sig4(g0) * acc[ai][1][m][0], o1 = g1 * sig4(g1) * acc[ai][1][m][1];
                *(u32x4*)(O + (size_t)r * DFF + col0) = pack8(o0, o1); }
    }
};

struct TDesc { const float* src; bf16_t* dst; int ld, ldd; };
__device__ __forceinline__ TDesc tile_desc(const Params& P, int t) {
    unsigned char* ws = P.ws; TDesc d; int tl, nkt;
    if (t < 2304) { tl = t; nkt = 16; const int kt = tl % nkt, nt = tl / nkt; const int n0 = nt * 64; d.ld = 9224; d.ldd = 2048;
        d.src = P.in[8] + (size_t)kt * 128 * d.ld + n0 + (n0 >= 5120 ? 8 : 0); d.dst = (bf16_t*)(ws + O_WINT) + (size_t)n0 * d.ldd + kt * 128; }
    else if (t < 2432) { tl = t - 2304; nkt = 8; const int kt = tl % nkt, nt = tl / nkt; d.ld = 1024; d.ldd = 1024;
        d.src = P.in[18] + (size_t)kt * 128 * d.ld + nt * 64; d.dst = (bf16_t*)(ws + O_WGLUT) + (size_t)nt * 64 * d.ldd + kt * 128; }
    else if (t < 2688) { tl = t - 2432; nkt = 8; const int kt = tl % nkt, nt = tl / nkt; d.ld = 2048; d.ldd = 1024;
        d.src = P.in[20] + (size_t)kt * 128 * d.ld + nt * 64; d.dst = (bf16_t*)(ws + O_WAT) + (size_t)nt * 64 * d.ldd + kt * 128; }
    else if (t < 2944) { tl = t - 2688; nkt = 8; const int kt = tl % nkt, nt = tl / nkt; d.ld = 2048; d.ldd = 1024;
        d.src = P.in[22] + (size_t)kt * 128 * d.ld + nt * 64; d.dst = (bf16_t*)(ws + O_WBT) + (size_t)nt * 64 * d.ldd + kt * 128; }
    else if (t < 3456) { tl = t - 2944; nkt = 16; const int kt = tl % nkt, nt = tl / nkt; d.ld = 2048; d.ldd = 2048;
        d.src = P.in[23] + (size_t)kt * 128 * d.ld + nt * 64; d.dst = (bf16_t*)(ws + O_WOUTT) + (size_t)nt * 64 * d.ldd + kt * 128; }
    else if (t < 6272) { tl = t - 3456; nkt = 16; const int kt = tl % nkt, nt = tl / nkt; d.ld = DFF; d.ldd = 2048;
        const int rp = nt * 64, pn = rp >> 8, half = (rp >> 7) & 1, idx = rp & 127;
        d.src = (half ? P.in[27] : P.in[26]) + (size_t)kt * 128 * d.ld + pn * 128 + idx; d.dst = (bf16_t*)(ws + O_WGUT) + (size_t)rp * d.ldd + kt * 128; }
    else { tl = t - 6272; nkt = 44; const int kt = tl % nkt, nt = tl / nkt; d.ld = 2048; d.ldd = DFF;
        d.src = P.in[28] + (size_t)kt * 128 * d.ld + nt * 64; d.dst = (bf16_t*)(ws + O_WDT) + (size_t)nt * 64 * d.ldd + kt * 128; }
    return d;
}
__device__ __forceinline__ void phase0(const Params& P, unsigned char* shm) {
    float* tile = (float*)shm;
    unsigned char* ws = P.ws;
    const int tid = threadIdx.x, lane = tid & 63, wave = tid >> 6;
    {
        const int r0 = tid >> 4, c4 = tid & 15;
        int t = blockIdx.x; f32x4 v[4]; TDesc d = tile_desc(P, t < 2304 ? t : 0);
        if (t < 2304) {
#pragma unroll
            for (int i = 0; i < 4; ++i) v[i] = *(const f32x4*)(d.src + (size_t)(r0 + 32 * i) * d.ld + c4 * 4); }
        while (t < 2304) {
            const int tn = t + gridDim.x; f32x4 vn[4]; TDesc dn = tile_desc(P, tn < 2304 ? tn : 0);
            if (tn < 2304) {
#pragma unroll
                for (int i = 0; i < 4; ++i) vn[i] = *(const f32x4*)(dn.src + (size_t)(r0 + 32 * i) * dn.ld + c4 * 4); }
#pragma unroll
            for (int i = 0; i < 4; ++i) { float* tp = tile + (r0 + 32 * i) * 65 + c4 * 4; tp[0] = v[i][0]; tp[1] = v[i][1]; tp[2] = v[i][2]; tp[3] = v[i][3]; }
            __syncthreads();
            { const int n = tid >> 3, kc = tid & 7; float x[16];
#pragma unroll
              for (int j = 0; j < 8; ++j) { x[j] = tile[(kc * 8 + j) * 65 + n]; x[8 + j] = tile[(64 + kc * 8 + j) * 65 + n]; }
              u32x4 w0, w1; w0.x = cvt_pk_bf16(x[0], x[1]); w0.y = cvt_pk_bf16(x[2], x[3]); w0.z = cvt_pk_bf16(x[4], x[5]); w0.w = cvt_pk_bf16(x[6], x[7]);
              w1.x = cvt_pk_bf16(x[8], x[9]); w1.y = cvt_pk_bf16(x[10], x[11]); w1.z = cvt_pk_bf16(x[12], x[13]); w1.w = cvt_pk_bf16(x[14], x[15]);
              bf16_t* dp = d.dst + (size_t)n * d.ldd + kc * 8; *(u32x4*)dp = w0; *(u32x4*)(dp + 64) = w1; }
            __syncthreads();
            t = tn; d = dn;
#pragma unroll
            for (int i = 0; i < 4; ++i) v[i] = vn[i];
        }
    }
    float* wgT = (float*)shm;
    for (int i = tid; i < 2048 * 2; i += 512) { const int k = i >> 1, hh = i & 1; const f32x4 v = *(const f32x4*)(P.in[8] + (size_t)k * 9224 + 5120 + hh * 4);
        wgT[(hh * 4 + 0) * 2048 + k] = v[0]; wgT[(hh * 4 + 1) * 2048 + k] = v[1]; wgT[(hh * 4 + 2) * 2048 + k] = v[2]; wgT[(hh * 4 + 3) * 2048 + k] = v[3]; }
    __syncthreads();
    bf16_t* XB = (bf16_t*)(ws + O_XB); float* gif = (float*)(ws + O_GIF);
    for (int row = blockIdx.x * 8 + wave; row < MP; row += gridDim.x * 8) {
        const float* xr = row < ROW_S ? P.in[0] + (size_t)row * D : row < ROW_META ? P.in[1] + (size_t)(row - ROW_S) * D : row < ROW_META + 16 ? P.in[7] + (size_t)(row - ROW_META) * D : nullptr;
        float s[8];
#pragma unroll
        for (int q = 0; q < 8; ++q) s[q] = 0.f;
        f32x4 xv[8];
#pragma unroll
        for (int i = 0; i < 8; ++i) { xv[i] = (f32x4){0.f, 0.f, 0.f, 0.f}; if (xr) xv[i] = __builtin_nontemporal_load((const f32x4*)(xr + lane * 4 + 256 * i)); }
#pragma unroll
        for (int i = 0; i < 8; ++i) { const int k = lane * 4 + 256 * i; const f32x4 v = xv[i];
            u32x2 w; w.x = cvt_pk_bf16(v[0], v[1]); w.y = cvt_pk_bf16(v[2], v[3]); *(u32x2*)(XB + (size_t)row * D + k) = w;
#pragma unroll
            for (int q = 0; q < 8; ++q) { const f32x4 wv = *(const f32x4*)(wgT + q * 2048 + k); s[q] += v[0] * wv[0] + v[1] * wv[1] + v[2] * wv[2] + v[3] * wv[3]; }
            asm volatile("" ::: "memory"); }
#pragma unroll
        for (int q = 0; q < 8; ++q) s[q] = wave_sum(s[q]);
        if (lane == 0) {
#pragma unroll
            for (int q = 0; q < 8; ++q) gif[(size_t)row * 8 + q] = xr ? s[q] + P.in[9][q] : 0.f; }
    }
    __syncthreads();
}

__device__ __forceinline__ void convert_dynamic(const Params& P, unsigned char* shm, unsigned* ctr, int t0, int t1) {
    float* tile = (float*)shm; volatile int* sh_t = (volatile int*)(shm + 36864);
    const int tid = threadIdx.x, r0 = tid >> 4, c4 = tid & 15;
    for (;;) {
        if (tid == 0) *sh_t = t0 + 4 * (int)__hip_atomic_fetch_add(ctr, 1u, __ATOMIC_RELAXED, __HIP_MEMORY_SCOPE_AGENT);
        __syncthreads();
        const int t = *sh_t;
        if (t >= t1) break;
        TDesc d[4]; f32x4 v[4][4];
#pragma unroll
        for (int h = 0; h < 4; ++h) { d[h] = tile_desc(P, t + h < t1 ? t + h : t);
#pragma unroll
            for (int i = 0; i < 4; ++i) v[h][i] = *(const f32x4*)(d[h].src + (size_t)(r0 + 32 * i) * d[h].ld + c4 * 4); }
#pragma unroll
        for (int h = 0; h < 4; ++h) {
            if (t + h < t1) {
#pragma unroll
                for (int i = 0; i < 4; ++i) { float* tp = tile + (r0 + 32 * i) * 65 + c4 * 4; tp[0] = v[h][i][0]; tp[1] = v[h][i][1]; tp[2] = v[h][i][2]; tp[3] = v[h][i][3]; }
                __syncthreads();
                { const int n = tid >> 3, kc = tid & 7; float x[16];
#pragma unroll
                  for (int jj = 0; jj < 8; ++jj) { x[jj] = tile[(kc * 8 + jj) * 65 + n]; x[8 + jj] = tile[(64 + kc * 8 + jj) * 65 + n]; }
                  u32x4 w0, w1; w0.x = cvt_pk_bf16(x[0], x[1]); w0.y = cvt_pk_bf16(x[2], x[3]); w0.z = cvt_pk_bf16(x[4], x[5]); w0.w = cvt_pk_bf16(x[6], x[7]);
                  w1.x = cvt_pk_bf16(x[8], x[9]); w1.y = cvt_pk_bf16(x[10], x[11]); w1.z = cvt_pk_bf16(x[12], x[13]); w1.w = cvt_pk_bf16(x[14], x[15]);
                  bf16_t* dp = d[h].dst + (size_t)n * d[h].ldd + kc * 8; *(u32x4*)dp = w0; *(u32x4*)(dp + 64) = w1; }
                __syncthreads();
            }
        }
    }
    __syncthreads();
}

__device__ __forceinline__ void gate_chain(const float* gif, int b, int h, int j, float* sm) {
    const int tid = threadIdx.x, lane = tid & 63, wave = tid >> 6;
    for (int i = wave; i <= j; i += 8) {
        const int Li = i == 0 ? 16 : 128; const int rowb = i == 0 ? ROW_META : b * 2048 + (i - 1) * 128;
        const int t0 = 2 * lane;
        float f0 = 0.f, f1 = 0.f, i0 = -INFINITY, i1 = -INFINITY;
        if (t0 < Li) { const float* gp = gif + (size_t)(rowb + t0) * 8; i0 = gp[h]; f0 = logsig(gp[4 + h]); i1 = gp[8 + h]; f1 = logsig(gp[12 + h]); }
        const float s = f0 + f1; const float incl = wave_incl_scan(s, lane); const float excl = incl - s;
        const float b0 = excl + f0, b1 = incl;
        const float a0 = i0 - b0, a1 = i1 - b1;
        const float amax = wave_max(fmaxf(a0, a1)); const float btot = __shfl(incl, 63);
        if (lane == 0) { sm[256 + i] = btot; sm[288 + i] = amax; }
        if (i == j) { sm[t0] = a0; sm[t0 + 1] = a1; sm[128 + t0] = b0; sm[128 + t0 + 1] = b1; }
    }
    __syncthreads();
    if (tid == 0) { float m = 0.f; for (int i = 0; i < j; ++i) m = sm[256 + i] + fmaxf(m, sm[288 + i]); sm[320] = m; }
    __syncthreads();
}

__device__ __forceinline__ void gate_chain_gst(const float* gif, const float* gst, int bh, int j, float* sm) {
    const int tid = threadIdx.x, lane = tid & 63, wave = tid >> 6; const int b = bh >> 2, h = bh & 3;
    if (wave == 0) {
        const int rowb = b * 2048 + (j - 1) * 128; const int t0 = 2 * lane;
        const float* gp = gif + (size_t)(rowb + t0) * 8; const float i0 = gp[h], f0 = logsig(gp[4 + h]), i1 = gp[8 + h], f1 = logsig(gp[12 + h]);
        const float s = f0 + f1; const float incl = wave_incl_scan(s, lane); const float excl = incl - s;
        const float b0 = excl + f0, b1 = incl;
        sm[t0] = i0 - b0; sm[t0 + 1] = i1 - b1; sm[128 + t0] = b0; sm[128 + t0 + 1] = b1;
    } else if (wave == 1 && lane < j) { sm[256 + lane] = gst[(bh * 17 + lane) * 2]; sm[288 + lane] = gst[(bh * 17 + lane) * 2 + 1]; }
    __syncthreads();
    if (tid == 0) { float m = 0.f; for (int i = 0; i < j; ++i) m = sm[256 + i] + fmaxf(m, sm[288 + i]); sm[320] = m; }
    __syncthreads();
}

__device__ __forceinline__ void mlstm_local(const Params& P, unsigned char* shm, int bh, int j) {
    const int tid = threadIdx.x, lane = tid & 63, wave = tid >> 6, l16 = lane & 15, q = lane >> 4;
    const int b = bh >> 2, h = bh & 3;
    bf16_t* Kt = (bf16_t*)shm; bf16_t* Vt = (bf16_t*)(shm + 69632); float* sm = (float*)(shm + SM_OFF);
    const float* gif = (const float*)(P.ws + O_GIF); const bf16_t* PROJ = (const bf16_t*)(P.ws + O_PROJ);
    gate_chain(gif, b, h, j, sm);
    const float m_in = sm[320]; const float Ml = fmaxf(m_in, sm[288 + j]);
    if (tid == 0) { float* gst = (float*)(P.ws + O_GST); gst[(bh * 17 + j) * 2] = sm[256 + j]; gst[(bh * 17 + j) * 2 + 1] = sm[288 + j]; }
    const int L = j == 0 ? 16 : 128; const int rowb = j == 0 ? ROW_META : b * 2048 + (j - 1) * 128;
    const int niter = j == 0 ? 2 : 8;
#pragma unroll 2
    for (int i = 0; i < niter; ++i) { const int item = tid + 512 * i; const int s = ((item >> 9) << 4) | (item & 15), c8 = (item >> 4) & 31;
        u32x4 kw = (u32x4){0u, 0u, 0u, 0u}, vw = (u32x4){0u, 0u, 0u, 0u}; float w = 0.f;
        if (s < L) { const bf16_t* rp = PROJ + (size_t)(rowb + s) * NPROJ + h * 256 + c8 * 8; kw = *(const u32x4*)(rp + C_K); vw = *(const u32x4*)(rp + C_V); w = __expf(sm[s] - Ml) * 0.0625f; }
        f32x4 k0, k1; unpack8(kw, k0, k1);
        bf16_t* kd = Kt + (size_t)(c8 * 8) * 136 + s; bf16_t* vd = Vt + (size_t)(c8 * 8) * 136 + s;
        kd[0 * 136] = f2bf(k0[0] * w); kd[1 * 136] = f2bf(k0[1] * w); kd[2 * 136] = f2bf(k0[2] * w); kd[3 * 136] = f2bf(k0[3] * w);
        kd[4 * 136] = f2bf(k1[0] * w); kd[5 * 136] = f2bf(k1[1] * w); kd[6 * 136] = f2bf(k1[2] * w); kd[7 * 136] = f2bf(k1[3] * w);
        vd[0 * 136] = (bf16_t)(vw.x & 0xffffu); vd[1 * 136] = (bf16_t)(vw.x >> 16); vd[2 * 136] = (bf16_t)(vw.y & 0xffffu); vd[3 * 136] = (bf16_t)(vw.y >> 16);
        vd[4 * 136] = (bf16_t)(vw.z & 0xffffu); vd[5 * 136] = (bf16_t)(vw.z >> 16); vd[6 * 136] = (bf16_t)(vw.w & 0xffffu); vd[7 * 136] = (bf16_t)(vw.w >> 16); }
    __syncthreads();
    const int nks = j == 0 ? 1 : 4;
    float* LOCT = (float*)(P.ws + O_LOCT) + (size_t)(bh * 17 + j) * 65536;
#pragma unroll 1
    for (int nh = 0; nh < 2; ++nh) {
        f32x4 acc[2][8];
#pragma unroll
        for (int m = 0; m < 2; ++m)
#pragma unroll
            for (int n = 0; n < 8; ++n) acc[m][n] = (f32x4){0.f, 0.f, 0.f, 0.f};
#pragma unroll 1
        for (int ks = 0; ks < nks; ++ks) {
            const bf16x8 a0 = *(const bf16x8*)(Vt + (size_t)(32 * wave + l16) * 136 + 32 * ks + 8 * q);
            const bf16x8 a1 = *(const bf16x8*)(Vt + (size_t)(32 * wave + 16 + l16) * 136 + 32 * ks + 8 * q);
#pragma unroll
            for (int n = 0; n < 8; ++n) { const bf16x8 bb = *(const bf16x8*)(Kt + (size_t)(128 * nh + 16 * n + l16) * 136 + 32 * ks + 8 * q);
                acc[0][n] = mfma16(a0, bb, acc[0][n]); acc[1][n] = mfma16(a1, bb, acc[1][n]); }
        }
        MFMA_SETTLE();
#pragma unroll
        for (int m = 0; m < 2; ++m)
#pragma unroll
            for (int r = 0; r < 4; ++r) { float* rp = LOCT + (size_t)(32 * wave + 16 * m + 4 * q + r) * 256 + 128 * nh + l16;
#pragma unroll
                for (int n = 0; n < 8; ++n) rp[16 * n] = acc[m][n][r]; }
    }
    if (tid < 256) { float s = 0.f; const u32x4* kp = (const u32x4*)(Kt + (size_t)tid * 136);
        for (int i = 0; i < (j == 0 ? 4 : 16); ++i) { const u32x4 w = kp[i]; s += bflo(w.x) + bfhi(w.x) + bflo(w.y) + bfhi(w.y) + bflo(w.z) + bfhi(w.z) + bflo(w.w) + bfhi(w.w); }
        ((float*)(P.ws + O_NLOC))[(bh * 17 + j) * 256 + tid] = s; }
    __syncthreads();
}

__device__ __forceinline__ void mlstm_decode_wave(const Params& P, unsigned char* wl, int sh) {
    const int lane = threadIdx.x & 63; const int bs = sh >> 2, h = sh & 3, row = ROW_S + bs;
    float* sq = (float*)wl; float* sk = sq + 256;
    const float* gif = (const float*)(P.ws + O_GIF); const bf16_t* PROJ = (const bf16_t*)(P.ws + O_PROJ);
    const bf16_t* rp = PROJ + (size_t)row * NPROJ + h * 256 + 4 * lane;
    const u32x2 qw = *(const u32x2*)(rp + C_Q), kw = *(const u32x2*)(rp + C_K), vw = *(const u32x2*)(rp + C_V), ow = *(const u32x2*)(rp + C_O);
    const f32x4 q4 = (f32x4){bflo(qw.x), bfhi(qw.x), bflo(qw.y), bfhi(qw.y)};
    const f32x4 k4 = (f32x4){bflo(kw.x), bfhi(kw.x), bflo(kw.y), bfhi(kw.y)} * 0.0625f;
    const f32x4 v4 = (f32x4){bflo(vw.x), bfhi(vw.x), bflo(vw.y), bfhi(vw.y)};
    const f32x4 o4 = (f32x4){bflo(ow.x), bfhi(ow.x), bflo(ow.y), bfhi(ow.y)};
    const f32x4 n4 = *(const f32x4*)(P.in[5] + (size_t)sh * 256 + 4 * lane);
    *(f32x4*)(sq + 4 * lane) = q4; *(f32x4*)(sk + 4 * lane) = k4;
    const float ig = gif[(size_t)row * 8 + h], fl = logsig(gif[(size_t)row * 8 + 4 + h]), m0 = P.in[6][sh];
    const float mt = fmaxf(fl + m0, ig), wi = __expf(ig - mt), wc = __expf(fl + m0 - mt);
    const float qk = wave_sum(q4[0] * k4[0] + q4[1] * k4[1] + q4[2] * k4[2] + q4[3] * k4[3]);
    const float qn = wave_sum(q4[0] * n4[0] + q4[1] * n4[1] + q4[2] * n4[2] + q4[3] * n4[3]);
    asm volatile("s_waitcnt lgkmcnt(0)" ::: "memory");
    const float* C0 = P.in[4] + (size_t)sh * 65536 + 4 * lane; float* C1 = P.out + OUT_SC + (size_t)sh * 65536 + 4 * lane;
    f32x4 part = (f32x4){0.f, 0.f, 0.f, 0.f}; const f32x4 wv = wi * v4;
#pragma unroll 1
    for (int dk0 = 0; dk0 < 256; dk0 += 32) { f32x4 c[32];
#pragma unroll
        for (int i = 0; i < 32; ++i) c[i] = __builtin_nontemporal_load((const f32x4*)(C0 + (dk0 + i) * 256));
#pragma unroll
        for (int i = 0; i < 32; ++i) { const float qd = sq[dk0 + i], kd = sk[dk0 + i]; part += qd * c[i]; __builtin_nontemporal_store(wc * c[i] + kd * wv, (f32x4*)(C1 + (dk0 + i) * 256)); } }
    const float s = qk * wi; const f32x4 num = wc * part + s * v4; const float den = wc * qn + s;
    const float dinv = 1.0f / fmaxf(fabsf(den), __expf(-mt));
    f32x4 hv = num * dinv;
    const float mean = wave_sum((hv[0] + hv[1]) + (hv[2] + hv[3])) * (1.0f / 256.0f);
    hv -= mean;
    const float var = wave_sum((hv[0] * hv[0] + hv[1] * hv[1]) + (hv[2] * hv[2] + hv[3] * hv[3])) * (1.0f / 256.0f);
    const float rstd = rsqrtf(var + EPS);
    const f32x4 gn = *(const f32x4*)(P.in[21] + h * 256 + 4 * lane);
    const f32x4 y = sig4(o4) * hv * rstd * gn;
    u32x2 yw; yw.x = cvt_pk_bf16(y[0], y[1]); yw.y = cvt_pk_bf16(y[2], y[3]);
    *(u32x2*)((bf16_t*)(P.ws + O_YB) + (size_t)row * 1024 + h * 256 + 4 * lane) = yw;
    *(f32x4*)(P.out + OUT_SN + (size_t)sh * 256 + 4 * lane) = wc * n4 + wi * k4;
    if (lane == 0) P.out[OUT_SM + sh] = mt;
    asm volatile("s_waitcnt lgkmcnt(0)" ::: "memory");
}

__device__ __forceinline__ void mlstm_prefix(const Params& P) {
    const int gtid = blockIdx.x * 512 + threadIdx.x, nth = gridDim.x * 512;
    const float* gst = (const float*)(P.ws + O_GST); const float* LOCT = (const float*)(P.ws + O_LOCT); bf16_t* CTB = (bf16_t*)(P.ws + O_CTB);
    for (int item = gtid; item < 16 * 16384; item += nth) {
        const int bh = item >> 14, idx4 = (item & 16383) * 4;
        f32x4 C = (f32x4){0.f, 0.f, 0.f, 0.f}; float m = 0.f;
#pragma unroll
        for (int j = 0; j < 17; ++j) { const float bt = gst[(bh * 17 + j) * 2], am = gst[(bh * 17 + j) * 2 + 1]; const float Ml = fmaxf(m, am), carry = __expf(m - Ml);
            if (j >= 1) { u32x2 w; w.x = cvt_pk_bf16(C[0], C[1]); w.y = cvt_pk_bf16(C[2], C[3]); *(u32x2*)(CTB + (size_t)(bh * 16 + j - 1) * 65536 + idx4) = w; }
            const f32x4 loc = *(const f32x4*)(LOCT + (size_t)(bh * 17 + j) * 65536 + idx4); C = carry * C + loc; m = bt + Ml; }
        const int dv = idx4 >> 8, dk = idx4 & 255; float* pc = P.out + OUT_PC + (size_t)bh * 65536;
#pragma unroll
        for (int e = 0; e < 4; ++e) pc[(size_t)(dk + e) * 256 + dv] = C[e];
    }
    const float* NLOC = (const float*)(P.ws + O_NLOC); float* NJ = (float*)(P.ws + O_NJ);
    for (int item = gtid; item < 4096; item += nth) {
        const int bh = item >> 8, dk = item & 255; float n = 0.f, m = 0.f;
        for (int j = 0; j < 17; ++j) { const float bt = gst[(bh * 17 + j) * 2], am = gst[(bh * 17 + j) * 2 + 1]; const float Ml = fmaxf(m, am), carry = __expf(m - Ml);
            NJ[(bh * 17 + j) * 256 + dk] = n; n = carry * n + NLOC[(bh * 17 + j) * 256 + dk]; m = bt + Ml; }
        P.out[OUT_PN + (size_t)bh * 256 + dk] = n; if (dk == 0) P.out[OUT_PM + bh] = m;
    }
}

__device__ __forceinline__ void mlstm_out(const Params& P, unsigned char* shm, int bh, int j) {
    const int tid = threadIdx.x, lane = tid & 63, wave = tid >> 6, l16 = lane & 15, q = lane >> 4;
    const int b = bh >> 2, h = bh & 3; const int rowb = b * 2048 + (j - 1) * 128;
    bf16_t* Qs = (bf16_t*)shm; bf16_t* Ss = (bf16_t*)(shm + 67584); float* sm = (float*)(shm + SM_OFF);
    float* sMt = sm + 384; float* sWi = sm + 512; float* sFl = sm + 640; float* sDen = sm + 768; float* sRow = sm + 896; float* sLN = sm + 1408; float* sMu = sm + 2432; float* sRs = sm + 2560;
    const float* gif = (const float*)(P.ws + O_GIF); const bf16_t* PROJ = (const bf16_t*)(P.ws + O_PROJ);
    const bf16_t* PR = PROJ + (size_t)rowb * NPROJ + h * 256;
    gate_chain_gst(gif, (const float*)(P.ws + O_GST), bh, j, sm);
    const float m_in = sm[320];
    float* sNj = sm + 2688;
    if (tid < 128) {
        float M = sm[tid];
#pragma unroll
        for (int o = 1; o < 64; o <<= 1) { const float t = __shfl_up(M, o); if (lane >= o) M = fmaxf(M, t); }
        if (tid == 63) sm[321] = M;
        asm volatile("s_waitcnt lgkmcnt(0)" ::: "memory");
        sMt[tid] = M; }
    else if (tid < 384) sNj[tid - 128] = ((const float*)(P.ws + O_NJ))[(bh * 17 + j) * 256 + tid - 128];
    __syncthreads();
    if (tid < 128) { float M = sMt[tid]; if (tid >= 64) M = fmaxf(M, sm[321]); M = fmaxf(M, m_in); sMt[tid] = M; sWi[tid] = __expf(m_in - M); sFl[tid] = __expf(-(sm[128 + tid] + M)); }
    { const int r = tid >> 5, c8 = tid & 31; const bf16_t* src = PR + r * NPROJ + C_Q + c8 * 8; bf16_t* dst = Qs + r * 264 + c8 * 8;
#pragma unroll
      for (int i = 0; i < 8; ++i) *(u32x4*)(dst + i * 16 * 264) = *(const u32x4*)(src + i * 16 * NPROJ); }
    __syncthreads();
    {
        const int wr2 = wave >> 2, wc4 = wave & 3;
        f32x4 acc[4][2];
#pragma unroll
        for (int m = 0; m < 4; ++m) { acc[m][0] = (f32x4){0.f, 0.f, 0.f, 0.f}; acc[m][1] = (f32x4){0.f, 0.f, 0.f, 0.f}; }
        const bf16_t* kbase = PR + (32 * wc4 + l16) * NPROJ + C_K + 8 * q;
        const bf16_t* qbase = Qs + (64 * wr2 + l16) * 264 + 8 * q;
#pragma unroll 2
        for (int ks = 0; ks < 8; ++ks) {
            const bf16x8 kf0 = *(const bf16x8*)(kbase + 32 * ks), kf1 = *(const bf16x8*)(kbase + 16 * NPROJ + 32 * ks);
#pragma unroll
            for (int m = 0; m < 4; ++m) { const bf16x8 a = *(const bf16x8*)(qbase + 16 * m * 264 + 32 * ks);
                acc[m][0] = mfma16(a, kf0, acc[m][0]); acc[m][1] = mfma16(a, kf1, acc[m][1]); } }
        MFMA_SETTLE();
        const int tb = 64 * wr2 + 4 * q, sb = 32 * wc4 + l16;
        const float as0 = sm[sb], as1 = sm[sb + 16];
        const float* pMt = sMt + tb; bf16_t* pSs = Ss + tb * 136 + sb; float* pRow = sRow + wc4 * 128 + tb;
#pragma unroll
        for (int m = 0; m < 4; ++m)
#pragma unroll
            for (int r = 0; r < 4; ++r) { const int t = tb + 16 * m + r; const float Mt = pMt[16 * m + r];
                float v0 = 0.f, v1 = 0.f; if (sb <= t) v0 = acc[m][0][r] * 0.0625f * __expf(as0 - Mt); if (sb + 16 <= t) v1 = acc[m][1][r] * 0.0625f * __expf(as1 - Mt);
                const bf16_t b0 = f2bf(v0), b1 = f2bf(v1); pSs[(16 * m + r) * 136] = b0; pSs[(16 * m + r) * 136 + 16] = b1;
                float rs = bf2f(b0) + bf2f(b1);
                rs = row16_sum(rs);
                if (l16 == 0) pRow[16 * m + r] = rs; }
    }
    __syncthreads();
    {
        const int t = tid >> 2, part = tid & 3; const float* nj = sNj + part * 64; const bf16_t* qp = Qs + t * 264 + part * 64;
        float s = 0.f;
#pragma unroll 8
        for (int i = 0; i < 64; ++i) s += bf2f(qp[i]) * nj[i];
        s += __shfl_xor(s, 1); s += __shfl_xor(s, 2);
        if (part == 0) { const float den = sWi[t] * s + sRow[t] + sRow[128 + t] + sRow[256 + t] + sRow[384 + t]; sDen[t] = 1.0f / fmaxf(fabsf(den), sFl[t]); }
    }
    f32x4 acc[8][2];
#pragma unroll
    for (int m = 0; m < 8; ++m) { acc[m][0] = (f32x4){0.f, 0.f, 0.f, 0.f}; acc[m][1] = (f32x4){0.f, 0.f, 0.f, 0.f}; }
    {
        const bf16_t* cbase = (const bf16_t*)(P.ws + O_CTB) + (size_t)(bh * 16 + j - 1) * 65536 + (32 * wave + l16) * 256 + 8 * q;
        const bf16_t* qbase = Qs + l16 * 264 + 8 * q;
#pragma unroll 2
        for (int ks = 0; ks < 8; ++ks) { const bf16x8 cf0 = *(const bf16x8*)(cbase + 32 * ks), cf1 = *(const bf16x8*)(cbase + 16 * 256 + 32 * ks);
#pragma unroll
            for (int m = 0; m < 8; ++m) { const bf16x8 a = *(const bf16x8*)(qbase + 16 * m * 264 + 32 * ks);
                acc[m][0] = mfma16(a, cf0, acc[m][0]); acc[m][1] = mfma16(a, cf1, acc[m][1]); } }
        MFMA_SETTLE();
        const float* pWi = sWi + 4 * q;
#pragma unroll
        for (int m = 0; m < 8; ++m)
#pragma unroll
            for (int r = 0; r < 4; ++r) { const float w = pWi[16 * m + r]; acc[m][0][r] *= w; acc[m][1][r] *= w; }
    }
    unsigned opk[8][4];
    { const bf16_t* obase = PR + (4 * q) * NPROJ + C_O + 32 * wave + l16;
#pragma unroll
      for (int m = 0; m < 8; ++m)
#pragma unroll
          for (int r = 0; r < 4; ++r) opk[m][r] = (unsigned)obase[(16 * m + r) * NPROJ] | ((unsigned)obase[(16 * m + r) * NPROJ + 16] << 16); }
    {
        const bf16_t* sbase = Ss + l16 * 136 + 8 * q;
#pragma unroll 1
        for (int ks = 0; ks < 4; ++ks) { bf16x8 vf0, vf1;
            const bf16_t* vp = PR + (32 * ks + 8 * q) * NPROJ + C_V + 32 * wave + l16;
#pragma unroll
            for (int e = 0; e < 8; ++e) { vf0[e] = (short)vp[e * NPROJ]; vf1[e] = (short)vp[e * NPROJ + 16]; }
#pragma unroll
            for (int m = 0; m < 8; ++m) { const bf16x8 a = *(const bf16x8*)(sbase + 16 * m * 136 + 32 * ks);
                acc[m][0] = mfma16(a, vf0, acc[m][0]); acc[m][1] = mfma16(a, vf1, acc[m][1]); } }
        MFMA_SETTLE();
    }
    __syncthreads();
    { const float* pDen = sDen + 4 * q; float* pLN = sLN + wave * 128 + 4 * q;
#pragma unroll
    for (int m = 0; m < 8; ++m)
#pragma unroll
        for (int r = 0; r < 4; ++r) { const float di = pDen[16 * m + r]; acc[m][0][r] *= di; acc[m][1][r] *= di;
            float s = acc[m][0][r] + acc[m][1][r]; s = row16_sum(s);
            if (l16 == 0) pLN[16 * m + r] = s; } }
    __syncthreads();
    if (tid < 128) { float s = 0.f;
#pragma unroll
        for (int w = 0; w < 8; ++w) s += sLN[w * 128 + tid];
        sMu[tid] = s * (1.0f / 256.0f); }
    __syncthreads();
    { const float* pMu = sMu + 4 * q; float* pLN = sLN + wave * 128 + 4 * q;
#pragma unroll
    for (int m = 0; m < 8; ++m)
#pragma unroll
        for (int r = 0; r < 4; ++r) { const float mu = pMu[16 * m + r]; acc[m][0][r] -= mu; acc[m][1][r] -= mu;
            float s = acc[m][0][r] * acc[m][0][r] + acc[m][1][r] * acc[m][1][r]; s = row16_sum(s);
            if (l16 == 0) pLN[16 * m + r] = s; } }
    __syncthreads();
    if (tid < 128) { float s = 0.f;
#pragma unroll
        for (int w = 0; w < 8; ++w) s += sLN[w * 128 + tid];
        sRs[tid] = rsqrtf(s * (1.0f / 256.0f) + EPS); }
    __syncthreads();
    const int col0 = h * 256 + 32 * wave + l16; const float gain0 = P.in[21][col0], gain1 = P.in[21][col0 + 16];
    bf16_t* ybase = (bf16_t*)(P.ws + O_YB) + (size_t)(rowb + 4 * q) * 1024 + col0; const float* pRs = sRs + 4 * q;
#pragma unroll
    for (int m = 0; m < 8; ++m)
#pragma unroll
        for (int r = 0; r < 4; ++r) { const float rs = pRs[16 * m + r]; const float o0 = bflo(opk[m][r]), o1 = bfhi(opk[m][r]);
            ybase[(16 * m + r) * 1024] = f2bf(sigmoidf_(o0) * acc[m][0][r] * rs * gain0); ybase[(16 * m + r) * 1024 + 16] = f2bf(sigmoidf_(o1) * acc[m][1][r] * rs * gain1); }
    __syncthreads();
}

__device__ __forceinline__ void s5_setup(const Params& P, int g, int p, float& ar, float& ai, float (&Br)[16], float (&Bi)[16]) {
    const int gp = g * 64 + p;
    const float lre = P.in[10][gp], lim = P.in[11][gp], dt = expf(P.in[12][gp]);
    const float zr = lre * dt, zi = lim * dt; const float er = expf(zr); float sn, cs; sincosf(zi, &sn, &cs);
    ar = er * cs; ai = er * sn;
    const float nr = ar - 1.0f, ni = ai, den = 1.0f / (lre * lre + lim * lim);
    const float cr = (nr * lre + ni * lim) * den, ci = (ni * lre - nr * lim) * den;
    const f32x4* bre = (const f32x4*)(P.in[13] + (size_t)gp * 16); const f32x4* bim = (const f32x4*)(P.in[14] + (size_t)gp * 16);
#pragma unroll
    for (int c4 = 0; c4 < 4; ++c4) { const f32x4 x = bre[c4], y = bim[c4];
#pragma unroll
        for (int e = 0; e < 4; ++e) { Br[c4 * 4 + e] = cr * x[e] - ci * y[e]; Bi[c4 * 4 + e] = cr * y[e] + ci * x[e]; } }
}
constexpr int S5_WL = 16896;
template <int MODE>
__device__ __forceinline__ void s5_unit(const Params& P, unsigned char* wl, const int id) {
    const int lane = threadIdx.x & 63, l16 = lane & 15, q = lane >> 4;
    bf16_t* Btab = (bf16_t*)wl; float* buf = (float*)(wl + 4096); unsigned* Hw = (unsigned*)(wl + 4096 + 8320); bf16_t* Ub = Btab;
    const bf16_t* PROJ = (const bf16_t*)(P.ws + O_PROJ); bf16_t* G = (bf16_t*)(P.ws + O_G);
    int g, row0, nblk, slot = 0, b = 0, c = 0, sb = 0;
    if (MODE == 0) { if (id < 3840) { g = id & 63; c = (id >> 6) % 15; b = id / 960; row0 = b * 2048 + c * 128; nblk = 8; slot = b * 16 + c; } else { g = id - 3840; row0 = ROW_META; nblk = 1; slot = 64; } }
    else if (MODE == 1) { g = id & 63; c = (id >> 6) & 15; b = id >> 10; row0 = b * 2048 + c * 128; nblk = 8; }
    else { g = id & 63; sb = id >> 6; row0 = ROW_S + sb * 16; nblk = 1; }
    float ar, ai; float Br[16], Bi[16];
    { s5_setup(P, g, lane, ar, ai, Br, Bi);
      u32x4 w[4], v[4];
#pragma unroll
      for (int i = 0; i < 4; ++i) { unsigned hw[4], lw[4];
#pragma unroll
          for (int e = 0; e < 4; ++e) { const int c0 = (i & 1) * 8 + 2 * e; const float x0 = (i < 2) ? Br[c0] : Bi[c0], x1 = (i < 2) ? Br[c0 + 1] : Bi[c0 + 1];
              const unsigned h = cvt_pk_bf16(x0, x1); hw[e] = h; lw[e] = cvt_pk_bf16(x0 - bflo(h), x1 - bfhi(h)); }
          w[i] = (u32x4){hw[0], hw[1], hw[2], hw[3]}; v[i] = (u32x4){lw[0], lw[1], lw[2], lw[3]}; }
      u32x4* bt = (u32x4*)(Btab + lane * 32); bt[0] = w[0]; bt[1] = w[1]; bt[2] = w[2]; bt[3] = w[3];
      u32x4* lt = (u32x4*)((bf16_t*)buf + lane * 32); lt[0] = v[0]; lt[1] = v[1]; lt[2] = v[2]; lt[3] = v[3]; }
    asm volatile("s_waitcnt lgkmcnt(0)" ::: "memory");
    const bf16x8 zf = (bf16x8){0, 0, 0, 0, 0, 0, 0, 0};
    bf16x8 bfr[8];
#pragma unroll
    for (int nn = 0; nn < 8; ++nn) bfr[nn] = *(const bf16x8*)((q < 2 ? Btab : (const bf16_t*)buf) + (16 * nn + l16) * 16 + 8 * (q & 1));
    asm volatile("s_waitcnt lgkmcnt(0)" ::: "memory");
    float hr = 0.f, hi = 0.f;
    if (MODE == 1) { float pr = ar, pi = ai;
#pragma unroll
        for (int i = 0; i < 7; ++i) { const float t = pr * pr - pi * pi; pi = 2.0f * pr * pi; pr = t; }
        const f32x2* E = (const f32x2*)(P.ws + O_ESSM);
        { const f32x2 e = E[(size_t)(64 * 64 + g) * 64 + lane]; hr = e.x; hi = e.y; }
        for (int i = 0; i < c; ++i) { const f32x2 e = E[(size_t)((b * 16 + i) * 64 + g) * 64 + lane]; const float nr_ = pr * hr - pi * hi + e.x, ni_ = pr * hi + pi * hr + e.y; hr = nr_; hi = ni_; } }
    bf16x8 cf[4]; float dsk = 0.f;
    if (MODE >= 1) {
#pragma unroll
        for (int ks = 0; ks < 4; ++ks) { const int p0 = 16 * ks + 4 * q; const f32x4 cr = *(const f32x4*)(P.in[15] + (size_t)(g * 16 + l16) * 64 + p0), ci = *(const f32x4*)(P.in[16] + (size_t)(g * 16 + l16) * 64 + p0);
            bf16x8 f; f[0] = (short)f2bf(cr[0]); f[1] = (short)f2bf(-ci[0]); f[2] = (short)f2bf(cr[1]); f[3] = (short)f2bf(-ci[1]); f[4] = (short)f2bf(cr[2]); f[5] = (short)f2bf(-ci[2]); f[6] = (short)f2bf(cr[3]); f[7] = (short)f2bf(-ci[3]); cf[ks] = f; }
        dsk = P.in[17][g * 16 + l16]; }
    const bf16_t* arow = PROJ + (size_t)(row0 + l16) * NPROJ + C_U + g * 16 + 8 * (q & 1);
    bf16x8 a_cur = *(const bf16x8*)arow;
    for (int blk = 0; blk < nblk; ++blk) {
        bf16x8 a_nxt = zf; if (blk + 1 < nblk) a_nxt = *(const bf16x8*)(arow + (size_t)(blk + 1) * 16 * NPROJ);
        { float* bp = buf + (4 * q) * 130 + l16; f32x4 d[8];
#pragma unroll
          for (int nn = 0; nn < 8; ++nn) d[nn] = mfma16(a_cur, bfr[nn], (f32x4){0.f, 0.f, 0.f, 0.f});
          __builtin_amdgcn_sched_barrier(0); asm volatile("s_nop 15\n\ts_nop 15" ::: "memory"); __builtin_amdgcn_sched_barrier(0);
#pragma unroll
          for (int nn = 0; nn < 8; ++nn) { bp[16 * nn] = d[nn][0]; bp[130 + 16 * nn] = d[nn][1]; bp[260 + 16 * nn] = d[nn][2]; bp[390 + 16 * nn] = d[nn][3]; } }
        if (MODE >= 1 && q < 2) *(bf16x8*)(Ub + l16 * 16 + 8 * q) = a_cur;
        asm volatile("s_waitcnt lgkmcnt(0)" ::: "memory");
#ifdef S5_DIAG
        if (MODE == 1) { float mxd = 0.f, mxa = 0.f;
        for (int t = 0; t < 16; ++t) { const u32x4* upp = (const u32x4*)(PROJ + (size_t)(row0 + blk * 16 + t) * NPROJ + C_U + g * 16); f32x4 ua, ub, uc, ud; unpack8(upp[0], ua, ub); unpack8(upp[1], uc, ud);
            float br = 0.f, bi = 0.f;
#pragma unroll
            for (int e = 0; e < 4; ++e) { br += Br[e] * ua[e] + Br[4 + e] * ub[e] + Br[8 + e] * uc[e] + Br[12 + e] * ud[e]; bi += Bi[e] * ua[e] + Bi[4 + e] * ub[e] + Bi[8 + e] * uc[e] + Bi[12 + e] * ud[e]; }
            const f32x2 mm = *(const f32x2*)(buf + t * 130 + 2 * lane);
            mxd = fmaxf(mxd, fmaxf(fabsf(mm.x - br), fabsf(mm.y - bi))); mxa = fmaxf(mxa, fmaxf(fabsf(br), fabsf(bi))); }
        mxd = wave_max(mxd); mxa = wave_max(mxa);
        if (lane == 0) { atomicMax((unsigned*)(P.ws + O_BAR) + 0, __float_as_uint(mxd)); atomicMax((unsigned*)(P.ws + O_BAR) + 1, __float_as_uint(mxa)); } }
#endif
#ifdef S5_EXACT
        for (int t = 0; t < 16; ++t) { const u32x4* upp = (const u32x4*)(PROJ + (size_t)(row0 + blk * 16 + t) * NPROJ + C_U + g * 16); f32x4 ua, ub, uc, ud; unpack8(upp[0], ua, ub); unpack8(upp[1], uc, ud);
            float br = 0.f, bi = 0.f;
#pragma unroll
            for (int e = 0; e < 4; ++e) { br += Br[e] * ua[e] + Br[4 + e] * ub[e] + Br[8 + e] * uc[e] + Br[12 + e] * ud[e]; bi += Bi[e] * ua[e] + Bi[4 + e] * ub[e] + Bi[8 + e] * uc[e] + Bi[12 + e] * ud[e]; }
            *(f32x2*)(buf + t * 130 + 2 * lane) = (f32x2){br, bi}; }
        asm volatile("s_waitcnt lgkmcnt(0)" ::: "memory");
#endif
        if (MODE == 2) {
#pragma unroll
            for (int t = 0; t < 16; ++t) { const size_t si = (size_t)((sb * 16 + t) * 64 + g) * 64 + lane; const float h0r = P.in[2][si], h0i = P.in[3][si];
                const f32x2 bb = *(const f32x2*)(buf + t * 130 + 2 * lane);
                const float nr_ = ar * h0r - ai * h0i + bb.x, ni_ = ar * h0i + ai * h0r + bb.y; P.out[OUT_SRE + si] = nr_; P.out[OUT_SIM + si] = ni_; Hw[t * 68 + lane] = cvt_pk_bf16(nr_, ni_); }
        } else {
            f32x2 bb[16];
#pragma unroll
            for (int t = 0; t < 16; ++t) bb[t] = *(const f32x2*)(buf + t * 130 + 2 * lane);
#pragma unroll
            for (int t = 0; t < 16; ++t) { const float nr_ = ar * hr - ai * hi + bb[t].x, ni_ = ar * hi + ai * hr + bb[t].y; hr = nr_; hi = ni_;
                if (MODE == 1) Hw[t * 68 + lane] = cvt_pk_bf16(hr, hi); }
        }
        if (MODE >= 1) {
            asm volatile("s_waitcnt lgkmcnt(0)" ::: "memory");
            f32x4 acc = (f32x4){0.f, 0.f, 0.f, 0.f};
#pragma unroll
            for (int ks = 0; ks < 4; ++ks) acc = mfma16(*(const bf16x8*)((const bf16_t*)Hw + l16 * 136 + 32 * ks + 8 * q), cf[ks], acc);
            __builtin_amdgcn_sched_barrier(0); asm volatile("s_nop 15\n\ts_nop 15" : "+v"(acc) :: "memory"); __builtin_amdgcn_sched_barrier(0);
            const bf16_t* up = Ub + (4 * q) * 16 + l16; bf16_t* gp = G + (size_t)(row0 + blk * 16 + 4 * q) * 1024 + g * 16 + l16;
#pragma unroll
            for (int r = 0; r < 4; ++r) { const float y = acc[r] + dsk * bf2f(up[r * 16]); gp[r * 1024] = f2bf(gelu_tanh(y)); }
        }
        asm volatile("s_waitcnt lgkmcnt(0)" ::: "memory");
        a_cur = a_nxt;
    }
    if (MODE == 0) ((f32x2*)(P.ws + O_ESSM))[(size_t)(slot * 64 + g) * 64 + lane] = (f32x2){hr, hi};
    if (MODE == 1 && c == 15) { P.out[OUT_PRE + (size_t)(b * 64 + g) * 64 + lane] = hr; P.out[OUT_PIM + (size_t)(b * 64 + g) * 64 + lane] = hi; }
}

template <int MODE>
__device__ __forceinline__ void skinny_phase(const Params& P, unsigned char* shm) {
    const int tid = threadIdx.x, lane = tid & 63, wave = tid >> 6, l16 = lane & 15, q = lane >> 4;
    float* red = (float*)shm;
    unsigned char* ws = P.ws;
    for (int tile = blockIdx.x; tile < 256; tile += gridDim.x) {
        const int mt = tile & 3, nt = tile >> 2;
        const bf16_t* A; const bf16_t* Bt; int ld, k0, nks;
        if (MODE == 0) { const int half = wave >> 2; A = (const bf16_t*)(ws + (half ? O_YB : O_YA)); Bt = (const bf16_t*)(ws + (half ? O_WBT : O_WAT)); ld = 1024; nks = 8; k0 = (wave & 3) * 256; }
        else if (MODE == 1) { A = (const bf16_t*)(ws + O_MIX); Bt = (const bf16_t*)(ws + O_WOUTT); ld = 2048; nks = 8; k0 = wave * 256; }
        else { A = (const bf16_t*)(ws + O_HFF); Bt = (const bf16_t*)(ws + O_WDT); ld = DFF; nks = 22; k0 = wave * 704; }
        const bf16_t* ap = A + (size_t)(ROW_S + 32 * mt + l16) * ld + k0 + 8 * q; const bf16_t* bp = Bt + (size_t)(32 * nt + l16) * ld + k0 + 8 * q;
        f32x4 acc[2][2];
#pragma unroll
        for (int i = 0; i < 2; ++i) { acc[i][0] = (f32x4){0.f, 0.f, 0.f, 0.f}; acc[i][1] = (f32x4){0.f, 0.f, 0.f, 0.f}; }
#pragma unroll 8
        for (int ks = 0; ks < nks; ++ks) { const bf16x8 a0 = *(const bf16x8*)(ap + 32 * ks), a1 = *(const bf16x8*)(ap + (size_t)16 * ld + 32 * ks), b0 = *(const bf16x8*)(bp + 32 * ks), b1 = *(const bf16x8*)(bp + (size_t)16 * ld + 32 * ks);
            acc[0][0] = mfma16(a0, b0, acc[0][0]); acc[0][1] = mfma16(a0, b1, acc[0][1]); acc[1][0] = mfma16(a1, b0, acc[1][0]); acc[1][1] = mfma16(a1, b1, acc[1][1]); }
        MFMA_SETTLE();
#pragma unroll
        for (int mi = 0; mi < 2; ++mi)
#pragma unroll
            for (int ni = 0; ni < 2; ++ni)
#pragma unroll
                for (int r = 0; r < 4; ++r) red[wave * 1024 + (16 * mi + 4 * q + r) * 32 + 16 * ni + l16] = acc[mi][ni][r];
        __syncthreads();
        { const int e = tid * 2, rr = e >> 5, cc = e & 31; const int row = ROW_S + 32 * mt + rr, col = 32 * nt + cc;
          float s0 = 0.f, s1 = 0.f, u0 = 0.f, u1 = 0.f;
#pragma unroll
          for (int w = 0; w < 4; ++w) { const f32x2 x = *(const f32x2*)(red + w * 1024 + e), y = *(const f32x2*)(red + (4 + w) * 1024 + e); s0 += x.x; s1 += x.y; u0 += y.x; u1 += y.y; }
          if (MODE == 0) { const bf16_t* gp = (const bf16_t*)(ws + O_PROJ) + (size_t)row * NPROJ + col;
              const unsigned ga = *(const unsigned*)(gp + C_GA), gb = *(const unsigned*)(gp + C_GB);
              const float m0 = sigmoidf_(bflo(ga)) * s0 + sigmoidf_(bflo(gb)) * u0, m1 = sigmoidf_(bfhi(ga)) * s1 + sigmoidf_(bfhi(gb)) * u1;
              *(unsigned*)((bf16_t*)(ws + O_MIX) + (size_t)row * D + col) = cvt_pk_bf16(m0, m1); }
          else if (MODE == 1) { const f32x2 xv = *(const f32x2*)(P.in[1] + (size_t)(row - ROW_S) * D + col);
              *(unsigned*)((bf16_t*)(ws + O_R) + (size_t)row * D + col) = cvt_pk_bf16(ALPHA * xv.x + s0 + u0, ALPHA * xv.y + s1 + u1); }
          else { const unsigned xw = *(const unsigned*)((const bf16_t*)(ws + O_X1B) + (size_t)row * D + col);
              *(unsigned*)((bf16_t*)(ws + O_R) + (size_t)row * D + col) = cvt_pk_bf16(ALPHA * bflo(xw) + s0 + u0, ALPHA * bfhi(xw) + s1 + u1); } }
        __syncthreads();
    }
}

__device__ __forceinline__ void ln_pass(const Params& P, const bf16_t* R, const float* gam, const float* bet, int mode) {
    const int lane = threadIdx.x & 63, wave = threadIdx.x >> 6;
    for (int row = blockIdx.x * 8 + wave; row < NREAL; row += gridDim.x * 8) {
        const bf16_t* rp = R + (size_t)row * D; f32x4 v[8]; float s = 0.f;
#pragma unroll
        for (int i = 0; i < 4; ++i) { unpack8(*(const u32x4*)(rp + lane * 8 + 512 * i), v[2 * i], v[2 * i + 1]); }
#pragma unroll
        for (int i = 0; i < 8; ++i) s += (v[i][0] + v[i][1]) + (v[i][2] + v[i][3]);
        const float mu = wave_sum(s) * (1.0f / D); float qv = 0.f;
#pragma unroll
        for (int i = 0; i < 8; ++i) { v[i] -= mu; qv += (v[i][0] * v[i][0] + v[i][1] * v[i][1]) + (v[i][2] * v[i][2] + v[i][3] * v[i][3]); }
        float rstd = rsqrtf(wave_sum(qv) * (1.0f / D) + EPS);
        float* op = row < ROW_S ? P.out + OUT_YP + (size_t)row * D : P.out + OUT_YS + (size_t)(row - ROW_S) * D;
#pragma unroll
        for (int i = 0; i < 4; ++i) { const int k = lane * 8 + 512 * i;
            const f32x4 o0 = v[2 * i] * rstd * *(const f32x4*)(gam + k) + *(const f32x4*)(bet + k), o1 = v[2 * i + 1] * rstd * *(const f32x4*)(gam + k + 4) + *(const f32x4*)(bet + k + 4);
            if (mode == 0) *(u32x4*)((bf16_t*)(P.ws + O_X1B) + (size_t)row * D + k) = pack8(o0, o1);
            else { __builtin_nontemporal_store(o0, (f32x4*)(op + k)); __builtin_nontemporal_store(o1, (f32x4*)(op + k + 4)); } }
    }
}

#define XB_TMO      128
#define XB_XCNT(j)  (256  + 64 * (j))
#define XB_XSUB(j)  (1280 + 64 * (j))
#define XB_XGEN(j)  (2304 + 64 * (j))
#define XB_TOP      3328
#define XB_TOPGEN   3392
#define XCD_BAR_WORDS 3456
#define XB_SPIN_CAP (1u << 22)
__device__ __forceinline__ unsigned xb_ld(unsigned* p)              { return __hip_atomic_load(p, __ATOMIC_RELAXED, __HIP_MEMORY_SCOPE_AGENT); }
__device__ __forceinline__ unsigned xb_add(unsigned* p, unsigned v) { return __hip_atomic_fetch_add(p, v, __ATOMIC_RELAXED, __HIP_MEMORY_SCOPE_AGENT); }
__device__ __forceinline__ unsigned xb_xcc_id() { return (unsigned)__builtin_amdgcn_s_getreg((3 << 11) | 20) & 0xFu; }
#define XB_SPIN(cond, bar) do { unsigned _sp = 0; while (cond) { __builtin_amdgcn_s_sleep(1); \
    if ((++_sp & 255u) == 0u) { if (xb_ld(&(bar)[XB_TMO])) break; if (_sp > XB_SPIN_CAP) { atomicAdd(&(bar)[XB_TMO], 1u); break; } } } } while (0)
struct XcdBarrier { unsigned* bar; unsigned x; volatile LAS unsigned* st; };
__device__ __forceinline__ XcdBarrier xcd_barrier_post(unsigned* bar, volatile LAS unsigned* st) {
    XcdBarrier b; b.bar = bar; b.x = xb_xcc_id(); b.st = st;
    if (threadIdx.x == 0) (void)xb_add(&bar[XB_XCNT(b.x)], 1u);
    return b;
}
__device__ __forceinline__ void xcd_barrier_complete(unsigned* bar, unsigned x, unsigned& nloc, unsigned& nx) {
    const unsigned G = gridDim.x * gridDim.y * gridDim.z;
    unsigned sum, cnt, mine, sp = 0u;
    for (;;) {
        sum = 0u; cnt = 0u; mine = 0u;
#pragma unroll
        for (unsigned j = 0; j < 16; ++j) { const unsigned c = xb_ld(&bar[XB_XCNT(j)]); sum += c; cnt += (c > 0u) ? 1u : 0u; mine = (j == x) ? c : mine; }
        if (sum == G) break;
        __builtin_amdgcn_s_sleep(1);
        if ((++sp & 255u) == 0u) { if (xb_ld(&bar[XB_TMO])) break; if (sp > XB_SPIN_CAP) { atomicAdd(&bar[XB_TMO], 1u); break; } }
    }
    nloc = mine > 0u ? mine : 1u; nx = cnt > 0u ? cnt : 1u;
}
__device__ __forceinline__ void xcd_barrier(const XcdBarrier& b) {
    asm volatile("s_waitcnt vmcnt(0)" ::: "memory");
    __syncthreads();
    if (threadIdx.x == 0) {
        unsigned* bar = b.bar;
        __builtin_amdgcn_s_waitcnt(0);
        unsigned nloc = b.st[0], nx = b.st[1];
        if (nloc == 0u) { xcd_barrier_complete(bar, b.x, nloc, nx); b.st[0] = nloc; b.st[1] = nx; }
        const unsigned old = xb_add(&bar[XB_XSUB(b.x)], 1u);
        const unsigned gen = old / nloc;
        if (old + 1u == (gen + 1u) * nloc) {
            __builtin_amdgcn_fence(__ATOMIC_RELEASE, "agent");
            asm volatile("s_waitcnt vmcnt(0)" ::: "memory");
            const unsigned og = xb_add(&bar[XB_TOP], 1u);
            const unsigned tg = og / nx;
            if (og + 1u == (tg + 1u) * nx) xb_add(&bar[XB_TOPGEN], 1u);
            else XB_SPIN(xb_ld(&bar[XB_TOPGEN]) == tg, bar);
            __builtin_amdgcn_fence(__ATOMIC_ACQUIRE, "agent");
            xb_add(&bar[XB_XGEN(b.x)], 1u);
            asm volatile("s_waitcnt vmcnt(0)" ::: "memory");
        } else {
            XB_SPIN(xb_ld(&bar[XB_XGEN(b.x)]) == gen, bar);
            __builtin_amdgcn_fence(__ATOMIC_ACQUIRE, "agent");
            asm volatile("s_waitcnt vmcnt(0)" ::: "memory");
        }
    }
    __syncthreads();
}

constexpr int NPHASE = 12;
__global__ void __launch_bounds__(512, 2) fwd(Params P) {
    extern __shared__ __attribute__((aligned(16))) unsigned char shm[];
    cg::grid_group grid = cg::this_grid();
    const int lo = P.ph_lo, hi = P.ph_hi;
    const int tid = threadIdx.x, wave = tid >> 6;
    unsigned char* ws = P.ws;
    volatile LAS unsigned* bst = (volatile LAS unsigned*)((LAS unsigned char*)shm + BARST_OFF);
    if (tid == 0) { bst[0] = 0u; bst[1] = 0u; }
    __syncthreads();
    XcdBarrier xbar = xcd_barrier_post((unsigned*)(ws + O_BAR), bst);
    if (hi > 1000) grid.sync();
#ifndef REP
#define REP 0
#endif
#define NREP(k) (1 + ((REP >> (k)) & 1))
#ifndef PHMASK
#define PHMASK 0xFFF
#endif
#define IN(k) (((PHMASK >> (k)) & 1) && lo <= (k) && (k) < hi)
#define SEAM(k) do { if ((k) + 1 < hi) xcd_barrier(xbar); } while (0)
    if (IN(0)) for (int rep_ = 0; rep_ < NREP(0); ++rep_) { phase0(P, shm); SEAM(0); }
    if (IN(1)) for (int rep_ = 0; rep_ < NREP(1); ++rep_) { pg8::Gemm g{(const bf16_t*)(ws + O_XB), (const bf16_t*)(ws + O_WINT), MP, NPROJ, D}; pg8::StaticOrder S; S.init(MP, NPROJ, gridDim.x, blockIdx.x, GREP1);
        EpiIn E{(bf16_t*)(ws + O_PROJ)}; pg8::gemm_phase<EpiIn>((LAS unsigned char*)shm, g, S, E);
        convert_dynamic(P, shm, (unsigned*)(ws + O_BAR) + 8, 2304, 3840); SEAM(1); }
    if (IN(2)) for (int rep_ = 0; rep_ < NREP(2); ++rep_) {
        for (int r2 = 0; r2 < NREP(14); ++r2) for (int u = blockIdx.x; u < 272; u += gridDim.x) { if (u < 256) mlstm_local(P, shm, u >> 4, (u & 15) + 1); else mlstm_local(P, shm, u - 256, 0); }
        __syncthreads();
        for (int r2 = 0; r2 < NREP(15); ++r2) for (int id = blockIdx.x * 8 + wave; id < 4672; id += gridDim.x * 8) {
            if (id < 2048 && (id & 7) == 0) { mlstm_decode_wave(P, shm + wave * S5_WL, id >> 3); continue; }
            const int sidx = id < 2048 ? id - (id >> 3) - 1 : 1792 + (id - 2048);
            if (sidx < 3904) s5_unit<0>(P, shm + wave * S5_WL, sidx); else s5_unit<2>(P, shm + wave * S5_WL, sidx - 3904); }
        SEAM(2); }
    if (IN(3)) for (int rep_ = 0; rep_ < NREP(3); ++rep_) { for (int r2 = 0; r2 < NREP(12); ++r2) mlstm_prefix(P);
        for (int r2 = 0; r2 < NREP(13); ++r2) for (int id = blockIdx.x * 8 + wave; id < 4352; id += gridDim.x * 8) {
            if (id < 2048 && (id & 7) == 0) { mlstm_decode_wave(P, shm + wave * S5_WL, 256 + (id >> 3)); continue; }
            s5_unit<1>(P, shm + wave * S5_WL, id < 2048 ? id - (id >> 3) - 1 : 1792 + (id - 2048)); }
        SEAM(3); }
    if (IN(4)) for (int rep_ = 0; rep_ < NREP(4); ++rep_) { for (int u = blockIdx.x; u < 256; u += gridDim.x) mlstm_out(P, shm, u >> 4, (u & 15) + 1); if (!IN(5)) SEAM(4); }
    if (IN(5)) for (int rep_ = 0; rep_ < NREP(5); ++rep_) { pg8::Gemm g{(const bf16_t*)(ws + O_G), (const bf16_t*)(ws + O_WGLUT), MP, 1024, 1024}; pg8::StaticOrder S; S.init(MP, 1024, gridDim.x, blockIdx.x);
        EpiGlu E{(const bf16_t*)(ws + O_G), (bf16_t*)(ws + O_YA), P.in[19]}; pg8::gemm_phase<EpiGlu>((LAS unsigned char*)shm, g, S, E);
        convert_dynamic(P, shm, (unsigned*)(ws + O_BAR) + 16, 3840, 6272); SEAM(5); }
    if (IN(6)) for (int rep_ = 0; rep_ < NREP(6); ++rep_) { pg8::StaticOrder S; S.init(ROW_S, D, gridDim.x, blockIdx.x);
        { pg8::Gemm g{(const bf16_t*)(ws + O_YA), (const bf16_t*)(ws + O_WAT), ROW_S, D, 1024}; EpiUpA E{(const bf16_t*)(ws + O_PROJ), (bf16_t*)(ws + O_TMP)}; pg8::gemm_phase<EpiUpA>((LAS unsigned char*)shm, g, S, E); }
        { pg8::Gemm g{(const bf16_t*)(ws + O_YB), (const bf16_t*)(ws + O_WBT), ROW_S, D, 1024}; EpiUpB E{(const bf16_t*)(ws + O_PROJ), (const bf16_t*)(ws + O_TMP), (bf16_t*)(ws + O_MIX)}; pg8::gemm_phase<EpiUpB>((LAS unsigned char*)shm, g, S, E); }
        skinny_phase<0>(P, shm);
        SEAM(6); }
    if (IN(7)) for (int rep_ = 0; rep_ < NREP(7); ++rep_) { pg8::Gemm g{(const bf16_t*)(ws + O_MIX), (const bf16_t*)(ws + O_WOUTT), ROW_S, D, D}; pg8::StaticOrder S; S.init(ROW_S, D, gridDim.x, blockIdx.x);
        EpiRes E{P.in[0], P.in[1], nullptr, 0, (bf16_t*)(ws + O_R)}; pg8::gemm_phase<EpiRes>((LAS unsigned char*)shm, g, S, E); skinny_phase<1>(P, shm); SEAM(7); }
    if (IN(8)) for (int rep_ = 0; rep_ < NREP(8); ++rep_) { ln_pass(P, (const bf16_t*)(ws + O_R), P.in[24], P.in[25], 0); SEAM(8); }
    if (IN(9)) for (int rep_ = 0; rep_ < NREP(9); ++rep_) { pg8::Gemm g{(const bf16_t*)(ws + O_X1B), (const bf16_t*)(ws + O_WGUT), MP, 2 * DFF, D}; pg8::StaticOrder S; S.init(MP, 2 * DFF, gridDim.x, blockIdx.x);
        EpiGU E{(bf16_t*)(ws + O_HFF)}; pg8::gemm_phase<EpiGU>((LAS unsigned char*)shm, g, S, E);
        convert_dynamic(P, shm, (unsigned*)(ws + O_BAR) + 24, 6272, 7680); SEAM(9); }
    if (IN(10)) for (int rep_ = 0; rep_ < NREP(10); ++rep_) { pg8::Gemm g{(const bf16_t*)(ws + O_HFF), (const bf16_t*)(ws + O_WDT), ROW_S, D, DFF}; pg8::StaticOrder S; S.init(ROW_S, D, gridDim.x, blockIdx.x, GREP10);
        EpiRes E{nullptr, nullptr, (const bf16_t*)(ws + O_X1B), 1, (bf16_t*)(ws + O_R)}; pg8::gemm_phase<EpiRes>((LAS unsigned char*)shm, g, S, E); skinny_phase<2>(P, shm); SEAM(10); }
    if (IN(11)) for (int rep_ = 0; rep_ < NREP(11); ++rep_) { ln_pass(P, (const bf16_t*)(ws + O_R), P.in[29], P.in[30], 1); }
#undef IN
#undef SEAM
}

extern "C" void kernel_launch(void* const* d_in, const int* in_sizes, int n_in, void* d_out, int out_size, void* d_ws, size_t ws_size, hipStream_t stream) {
    static int grid = 0;
    if (grid == 0) {
        if (n_in != 31 || ws_size < O_END) { fprintf(stderr, "kernel_launch: unexpected sizes n_in %d out %d ws %zu (need %zu)\n", n_in, out_size, ws_size, (size_t)O_END); grid = -1; return; }
        int dev = 0, cus = 0, per_cu = 0;
        hipGetDevice(&dev); hipDeviceGetAttribute(&cus, hipDeviceAttributeMultiprocessorCount, dev);
        if (hipFuncSetAttribute((const void*)fwd, hipFuncAttributeMaxDynamicSharedMemorySize, LDS_BYTES) != hipSuccess) { fprintf(stderr, "kernel_launch: hipFuncSetAttribute failed\n"); grid = -1; return; }
        if (hipOccupancyMaxActiveBlocksPerMultiprocessor(&per_cu, (const void*)fwd, 512, LDS_BYTES) != hipSuccess || per_cu < 1) { fprintf(stderr, "kernel_launch: occupancy query says %d\n", per_cu); per_cu = 1; }
        (void)hipGetLastError();
        grid = cus * 1;
    }
    if (grid < 0) return;
    Params p{};
    for (int i = 0; i < 31; ++i) p.in[i] = (const float*)d_in[i];
    p.out = (float*)d_out; p.ws = (unsigned char*)d_ws;
    (void)hipMemsetAsync((unsigned char*)d_ws + O_BAR, 0, XCD_BAR_WORDS * 4, stream);
#if ONE_LAUNCH
    p.ph_lo = 0; p.ph_hi = NPHASE;
    void* args[] = {&p};
    hipError_t e = hipLaunchCooperativeKernel((const void*)fwd, dim3(grid), dim3(512), args, LDS_BYTES, stream);
    if (e != hipSuccess) fprintf(stderr, "cooperative launch failed: %s (grid %d)\n", hipGetErrorString(e), grid);
#else
    for (int ph = 0; ph < NPHASE; ++ph) { p.ph_lo = ph; p.ph_hi = ph + 1; hipLaunchKernelGGL(fwd, dim3(grid), dim3(512), LDS_BYTES, stream, p); }
#endif
}
```

```cpp
#include <hip/hip_runtime.h>
#include <hip/hip_cooperative_groups.h>
#include <cstdio>
namespace cg = cooperative_groups;


#ifndef GREP1
#define GREP1 1
#endif
#ifndef GREP10
#define GREP10 1
#endif
#ifndef ONE_LAUNCH
#define ONE_LAUNCH 1
#endif

typedef unsigned short bf16_t;
typedef short bf16x8 __attribute__((ext_vector_type(8)));
typedef float f32x4 __attribute__((ext_vector_type(4)));
typedef float f32x2 __attribute__((ext_vector_type(2)));
typedef unsigned u32x4 __attribute__((ext_vector_type(4)));
typedef unsigned u32x2 __attribute__((ext_vector_type(2)));
#define LAS __attribute__((address_space(3)))

constexpr int D = 2048, MP = 8448, ROW_S = 8192, ROW_META = 8320, NREAL = 8320;
constexpr int NPROJ = 9216, DFF = 5632;
constexpr int C_U = 0, C_Q = 1024, C_K = 2048, C_V = 3072, C_O = 4096, C_GA = 5120, C_GB = 7168;
constexpr float EPS = 1e-5f;
constexpr float ALPHA = 1.189207115002721f;
constexpr int LDS_BYTES = 155648;
constexpr int SM_OFF = 139264;
constexpr int BARST_OFF = SM_OFF + 16000;

constexpr size_t O_XB = 0;
constexpr size_t O_WINT = O_XB + 34603008;
constexpr size_t O_GIF = O_WINT + 37748736;
constexpr size_t O_PROJ = O_GIF + 270336;
constexpr size_t O_WGLUT = O_PROJ + 155713536;
constexpr size_t O_WAT = O_WGLUT + 2097152;
constexpr size_t O_WBT = O_WAT + 4194304;
constexpr size_t O_WOUTT = O_WBT + 4194304;
constexpr size_t O_WGUT = O_WOUTT + 8388608;
constexpr size_t O_WDT = O_WGUT + 46137344;
constexpr size_t O_YB = O_WDT + 23068672;
constexpr size_t O_TMP = O_YB + 17301504;
constexpr size_t O_MIX = O_TMP + 69206016;
constexpr size_t O_R = O_MIX + 34603008;
constexpr size_t O_NLOC = O_R + 71303168;
constexpr size_t O_NJ = O_NLOC + 278528;
constexpr size_t O_GST = O_NJ + 278528;
constexpr size_t O_ESSM = O_GST + 4096;
constexpr size_t O_BAR = O_ESSM + 2129920;
constexpr size_t O_END = O_BAR + 16384;
constexpr size_t O_G = O_WINT, O_YA = O_WINT + 17301504, O_X1B = O_XB, O_HFF = O_PROJ, O_X1 = O_TMP, O_CTB = O_MIX, O_LOCT = O_R;

struct Params { const float* in[31]; float* out; unsigned char* ws; int ph_lo, ph_hi; };

constexpr size_t OUT_YP = 0, OUT_YS = 16777216, OUT_PRE = OUT_YS + 262144, OUT_PIM = OUT_PRE + 16384, OUT_PC = OUT_PIM + 16384,
                 OUT_PN = OUT_PC + 1048576, OUT_PM = OUT_PN + 4096, OUT_SRE = OUT_PM + 16, OUT_SIM = OUT_SRE + 524288, OUT_SC = OUT_SIM + 524288,
                 OUT_SN = OUT_SC + 33554432, OUT_SM = OUT_SN + 131072, OUT_END = OUT_SM + 512;

__device__ __forceinline__ unsigned cvt_pk_bf16(float lo, float hi) { unsigned r; asm volatile("v_cvt_pk_bf16_f32 %0, %1, %2" : "=v"(r) : "v"(lo), "v"(hi)); return r; }
__device__ __forceinline__ bf16_t f2bf(float f) { unsigned u = __float_as_uint(f); u += 0x7FFFu + ((u >> 16) & 1u); return (bf16_t)(u >> 16); }
__device__ __forceinline__ float bf2f(bf16_t b) { return __uint_as_float(((unsigned)b) << 16); }
__device__ __forceinline__ float bflo(unsigned w) { return __uint_as_float(w << 16); }
__device__ __forceinline__ float bfhi(unsigned w) { return __uint_as_float(w & 0xffff0000u); }
__device__ __forceinline__ float sigmoidf_(float x) { return __builtin_amdgcn_rcpf(1.0f + __expf(-x)); }
__device__ __forceinline__ float logsig(float x) { return fminf(x, 0.f) - log1pf(__expf(-fabsf(x))); }
__device__ __forceinline__ float gelu_tanh(float x) { const float z = 1.5957691216057308f * (x + 0.044715f * x * x * x); return x * sigmoidf_(z); }
template <int CTRL> __device__ __forceinline__ float dpp_mov(float x) { return __builtin_bit_cast(float, __builtin_amdgcn_update_dpp(0, __builtin_bit_cast(int, x), CTRL, 0xf, 0xf, false)); }
__device__ __forceinline__ float row16_sum(float x) { x += dpp_mov<0x128>(x); x += dpp_mov<0x124>(x); x += dpp_mov<0x122>(x); x += dpp_mov<0x121>(x); return x; }
__device__ __forceinline__ float row16_max(float x) { x = fmaxf(x, dpp_mov<0x128>(x)); x = fmaxf(x, dpp_mov<0x124>(x)); x = fmaxf(x, dpp_mov<0x122>(x)); x = fmaxf(x, dpp_mov<0x121>(x)); return x; }
__device__ __forceinline__ float lane_bcast(float x, int l) { return __builtin_bit_cast(float, __builtin_amdgcn_readlane(__builtin_bit_cast(int, x), l)); }
__device__ __forceinline__ float wave_sum(float v) { v = row16_sum(v); return (lane_bcast(v, 0) + lane_bcast(v, 16)) + (lane_bcast(v, 32) + lane_bcast(v, 48)); }
__device__ __forceinline__ float wave_max(float v) { v = row16_max(v); return fmaxf(fmaxf(lane_bcast(v, 0), lane_bcast(v, 16)), fmaxf(lane_bcast(v, 32), lane_bcast(v, 48))); }
__device__ __forceinline__ float wave_incl_scan(float v, int lane) {
#pragma unroll
    for (int o = 1; o < 64; o <<= 1) { const float t = __shfl_up(v, o); if (lane >= o) v += t; } return v; }
__device__ __forceinline__ float block_sum(float v, float* scratch) {
    v = wave_sum(v); if ((threadIdx.x & 63) == 0) scratch[threadIdx.x >> 6] = v; __syncthreads();
    float r = 0.f;
#pragma unroll
    for (int w = 0; w < 8; ++w) r += scratch[w];
    __syncthreads(); return r; }
__device__ __forceinline__ f32x4 mfma16(bf16x8 a, bf16x8 b, f32x4 c) { return __builtin_amdgcn_mfma_f32_16x16x32_bf16(a, b, c, 0, 0, 0); }
#define MFMA_SETTLE() do { __builtin_amdgcn_sched_barrier(0); asm volatile("s_nop 15\n\ts_nop 15" ::: "memory"); __builtin_amdgcn_sched_barrier(0); } while (0)

namespace pg8 {
constexpr int BM = 256, BK = 64, HALF = 128, HTB = HALF * BK * 2, STAGE_BYTES = 8 * HTB, NXCD = 8, WGM = 8;
__host__ __device__ __forceinline__ int lds_byte(int r, int c) { const int st = (r >> 4) * 2 + (c >> 5), rr = r & 15, cc = c & 31, ob = rr * 64 + cc * 2; return st * 1024 + (ob ^ (((ob >> 9) & 1) << 5)); }
__host__ __device__ __forceinline__ void stage_rc(int b, int& R, int& C) { const int st = b / 1024, sb = b % 1024, swz = sb ^ (((sb >> 9) & 1) << 5); R = (st >> 1) * 16 + swz / 64; C = (st & 1) * 32 + (swz % 64) / 2; }
__host__ __device__ __forceinline__ int perm32(int rho) { const int n = rho >> 4, i = rho & 15; return 8 * (i >> 2) + 4 * n + (i & 3); }
struct Unit { int pm, pn; };
struct Gemm { const bf16_t* A; const bf16_t* Bt; int M, N, K; };
struct StaticOrder {
    int nM, nN, nwg, G, c, rep;
    __device__ void init(int M, int N, int G_, int c_, int rep_ = 1) { nM = M / BM; nN = N / BM; nwg = nM * nN; G = G_; c = c_; rep = rep_; }
    __device__ bool next(int i, Unit& u) const {
        long L = (long)i * G + c; if (L >= (long)nwg * rep) return false;
        L %= nwg;
        int wgid = (int)L; { const int q = nwg / NXCD, r = nwg % NXCD, xcd = wgid % NXCD, off = wgid / NXCD; wgid = (xcd < r ? xcd * (q + 1) : r * (q + 1) + (xcd - r) * q) + off; }
        const int nig = WGM * nN, gid = wgid / nig, fm = gid * WGM, gsz = (nM - fm) < WGM ? (nM - fm) : WGM;
        u.pm = fm + ((wgid % nig) % gsz); u.pn = (wgid % nig) / gsz; return true;
    }
};

template <class Epi>
__device__ __forceinline__ void gemm_phase(LAS unsigned char* lds, const Gemm g, const StaticOrder& S, const Epi& E) {
    const int tid = threadIdx.x, wid = __builtin_amdgcn_readfirstlane(tid >> 6), lane = tid & 63, wr = wid >> 2, wc = wid & 3, fr = lane & 15, fq = lane >> 4;
    const int K = g.K, nt = K / BK;
    unsigned voffA[2], voffB[2];
#pragma unroll
    for (int i = 0; i < 2; ++i) { int R, C; stage_rc(tid * 16 + i * 8192, R, C); const int Rb = Epi::PERM ? ((R & ~31) + perm32(R & 31)) : R;
        voffA[i] = (unsigned)(R * K + C) * 2u; voffB[i] = (unsigned)(Rb * K + C) * 2u; }
    const size_t kstep = (size_t)(BK * 2);
    const size_t hstep = (size_t)HALF * K * 2;
    const size_t tstep = 2 * hstep;
    const unsigned ldsw = (unsigned)wid * 1024u;
    const int aoff = lds_byte(wr * 64 + fr, fq * 8), boff = lds_byte(wc * 32 + fr, fq * 8);
#define PG8_SA(b, h) (((b) * 2 + (h)) * HTB)
#define PG8_SB(b, h) ((4 + (b) * 2 + (h)) * HTB)
#define PG8_STAGE(bufoff, gbase, voff) do { _Pragma("unroll") for (int _i = 0; _i < 2; ++_i) \
        __builtin_amdgcn_global_load_lds((const unsigned*)((const char*)(gbase) + (voff)[_i]), (LAS unsigned*)(lds + (bufoff) + ldsw + _i * 8192), 16, 0, 0); } while (0)
#define PG8_LDA(dst, b, h) do { _Pragma("unroll") for (int m = 0; m < 4; ++m) _Pragma("unroll") for (int k = 0; k < 2; ++k) dst[m][k] = *(const LAS bf16x8*)(lds + PG8_SA(b, h) + aoff + m * 2048 + k * 1024); } while (0)
#define PG8_LDB(dst, b, h) do { _Pragma("unroll") for (int n = 0; n < 2; ++n) _Pragma("unroll") for (int k = 0; k < 2; ++k) dst[n][k] = *(const LAS bf16x8*)(lds + PG8_SB(b, h) + boff + n * 2048 + k * 1024); } while (0)
#define PG8_MMA(ai, bj, At, Bt) do { __builtin_amdgcn_s_setprio(1); _Pragma("unroll") for (int m = 0; m < 4; ++m) _Pragma("unroll") for (int n = 0; n < 2; ++n) _Pragma("unroll") for (int k = 0; k < 2; ++k) \
        acc[ai][bj][m][n] = __builtin_amdgcn_mfma_f32_16x16x32_bf16(Bt[n][k], At[m][k], acc[ai][bj][m][n], 0, 0, 0); __builtin_amdgcn_s_setprio(0); } while (0)
#define PG8_WAIT_V(n) asm volatile("s_waitcnt vmcnt(" #n ")" ::: "memory")
#define PG8_WAIT_L(n) asm volatile("s_waitcnt lgkmcnt(" #n ")" ::: "memory")
#define PG8_BAR __builtin_amdgcn_s_barrier()
#define PG8_SCHED __builtin_amdgcn_sched_barrier(0)
    Unit cur, nxt; int ui = 0;
    if (!S.next(0, cur)) return;
    f32x4 acc[2][2][4][2];
#pragma unroll
    for (int a = 0; a < 2; ++a)
#pragma unroll
        for (int b = 0; b < 2; ++b)
#pragma unroll
            for (int m = 0; m < 4; ++m)
#pragma unroll
                for (int n = 0; n < 2; ++n) acc[a][b][m][n] = (f32x4){0.f, 0.f, 0.f, 0.f};
    bf16x8 At[4][2], B0[2][2], B1[2][2];
    const char* cA = (const char*)g.A + (size_t)cur.pm * tstep; const char* cB = (const char*)g.Bt + (size_t)cur.pn * tstep;
    PG8_STAGE(PG8_SB(0, 0), cB, voffB); PG8_STAGE(PG8_SA(0, 0), cA, voffA); PG8_STAGE(PG8_SB(0, 1), cB + hstep, voffB); PG8_STAGE(PG8_SA(0, 1), cA + hstep, voffA);
    if (wr == 1) PG8_BAR;
    PG8_WAIT_V(4); PG8_BAR;
    PG8_STAGE(PG8_SB(1, 0), cB + kstep, voffB); PG8_STAGE(PG8_SA(1, 0), cA + kstep, voffA); PG8_STAGE(PG8_SB(1, 1), cB + hstep + kstep, voffB);
    PG8_WAIT_V(6); PG8_BAR;
    for (;;) {
        const bool has_next = S.next(ui + 1, nxt);
        const char* nA = has_next ? (const char*)g.A + (size_t)nxt.pm * tstep : cA; const char* nB = has_next ? (const char*)g.Bt + (size_t)nxt.pn * tstep : cB;
        for (int t = 0; t < nt; t += 2) {
            const bool last = (t == nt - 2);
            const char* a1 = cA + (size_t)(t + 1) * kstep;
            const char* a2 = last ? nA : cA + (size_t)(t + 2) * kstep; const char* b2 = last ? nB : cB + (size_t)(t + 2) * kstep;
            const char* a3 = a2 + kstep; const char* b3 = b2 + kstep;
            PG8_LDB(B0, 0, 0); PG8_SCHED; PG8_LDA(At, 0, 0); PG8_STAGE(PG8_SA(1, 1), a1 + hstep, voffA);
            PG8_WAIT_L(8); PG8_BAR; PG8_WAIT_L(0); PG8_MMA(0, 0, At, B0); PG8_BAR; PG8_SCHED;
            PG8_LDB(B1, 0, 1); PG8_STAGE(PG8_SB(0, 0), b2, voffB);
            PG8_BAR; PG8_WAIT_L(0); PG8_MMA(0, 1, At, B1); PG8_BAR;
            PG8_LDA(At, 0, 1); PG8_STAGE(PG8_SA(0, 0), a2, voffA);
            PG8_BAR; PG8_WAIT_L(0); PG8_MMA(1, 0, At, B0); PG8_BAR; PG8_SCHED;
            PG8_STAGE(PG8_SB(0, 1), b2 + hstep, voffB);
            PG8_WAIT_V(6); PG8_BAR; PG8_MMA(1, 1, At, B1); PG8_BAR;
            PG8_LDB(B0, 1, 0); PG8_SCHED; PG8_LDA(At, 1, 0); PG8_STAGE(PG8_SA(0, 1), a2 + hstep, voffA);
            PG8_WAIT_L(8); PG8_BAR; PG8_WAIT_L(0); PG8_MMA(0, 0, At, B0); PG8_BAR; PG8_SCHED;
            PG8_LDB(B1, 1, 1); PG8_STAGE(PG8_SB(1, 0), b3, voffB);
            PG8_BAR; PG8_WAIT_L(0); PG8_MMA(0, 1, At, B1); PG8_BAR;
            PG8_LDA(At, 1, 1); PG8_STAGE(PG8_SA(1, 0), a3, voffA);
            PG8_BAR; PG8_WAIT_L(0); PG8_MMA(1, 0, At, B0); PG8_BAR; PG8_SCHED;
            PG8_STAGE(PG8_SB(1, 1), b3 + hstep, voffB);
            PG8_WAIT_V(6); PG8_BAR; PG8_MMA(1, 1, At, B1); PG8_BAR;
        }
        E(acc, cur, wr, wc, fr, fq);
        if (!has_next) break;
#pragma unroll
        for (int a = 0; a < 2; ++a)
#pragma unroll
            for (int b = 0; b < 2; ++b)
#pragma unroll
                for (int m = 0; m < 4; ++m)
#pragma unroll
                    for (int n = 0; n < 2; ++n) acc[a][b][m][n] = (f32x4){0.f, 0.f, 0.f, 0.f};
        cur = nxt; cA = nA; cB = nB; ++ui;
    }
    PG8_WAIT_V(0);
    if (wr == 0) PG8_BAR;
    PG8_BAR;
#undef PG8_SA
#undef PG8_SB
#undef PG8_STAGE
#undef PG8_LDA
#undef PG8_LDB
#undef PG8_MMA
#undef PG8_WAIT_V
#undef PG8_WAIT_L
#undef PG8_BAR
#undef PG8_SCHED
}
}

typedef f32x4 AccT[2][2][4][2];
#define EPI_LOOP_ROWS for (int ai = 0; ai < 2; ++ai) for (int m = 0; m < 4; ++m)
__device__ __forceinline__ u32x4 pack8(const f32x4 v0, const f32x4 v1) { u32x4 w; w.x = cvt_pk_bf16(v0[0], v0[1]); w.y = cvt_pk_bf16(v0[2], v0[3]); w.z = cvt_pk_bf16(v1[0], v1[1]); w.w = cvt_pk_bf16(v1[2], v1[3]); return w; }
__device__ __forceinline__ void unpack8(const u32x4 w, f32x4& v0, f32x4& v1) { v0 = (f32x4){bflo(w.x), bfhi(w.x), bflo(w.y), bfhi(w.y)}; v1 = (f32x4){bflo(w.z), bfhi(w.z), bflo(w.w), bfhi(w.w)}; }
__device__ __forceinline__ f32x4 sig4(const f32x4 v) { return (f32x4){sigmoidf_(v[0]), sigmoidf_(v[1]), sigmoidf_(v[2]), sigmoidf_(v[3])}; }

struct EpiIn {
    static constexpr bool PERM = true; bf16_t* O;
    __device__ __forceinline__ void operator()(const AccT& acc, const pg8::Unit& u, int wr, int wc, int fr, int fq) const {
        const int row0 = u.pm * 256 + wr * 64 + fr, col0 = u.pn * 256 + wc * 32 + 8 * fq;
#pragma unroll
        for (int ai = 0; ai < 2; ++ai)
#pragma unroll
            for (int m = 0; m < 4; ++m) { bf16_t* rowp = O + (size_t)(row0 + ai * 128 + m * 16) * NPROJ + col0;
#pragma unroll
                for (int bj = 0; bj < 2; ++bj) *(u32x4*)(rowp + bj * 128) = pack8(acc[ai][bj][m][0], acc[ai][bj][m][1]); }
    }
};
struct EpiGlu {
    static constexpr bool PERM = true; const bf16_t* G; bf16_t* O; const float* bias;
    __device__ __forceinline__ void operator()(const AccT& acc, const pg8::Unit& u, int wr, int wc, int fr, int fq) const {
        const int row0 = u.pm * 256 + wr * 64 + fr, col0 = u.pn * 256 + wc * 32 + 8 * fq;
        f32x4 bv[2][2];
#pragma unroll
        for (int bj = 0; bj < 2; ++bj)
#pragma unroll
            for (int n = 0; n < 2; ++n) bv[bj][n] = *(const f32x4*)(bias + col0 + bj * 128 + 4 * n);
#pragma unroll
        for (int ai = 0; ai < 2; ++ai) { u32x4 gw[4][2];
#pragma unroll
            for (int m = 0; m < 4; ++m)
#pragma unroll
                for (int bj = 0; bj < 2; ++bj) gw[m][bj] = *(const u32x4*)(G + (size_t)(row0 + ai * 128 + m * 16) * 1024 + col0 + bj * 128);
#pragma unroll
            for (int m = 0; m < 4; ++m)
#pragma unroll
                for (int bj = 0; bj < 2; ++bj) { f32x4 g0, g1; unpack8(gw[m][bj], g0, g1);
                    *(u32x4*)(O + (size_t)(row0 + ai * 128 + m * 16) * 1024 + col0 + bj * 128) = pack8(g0 * sig4(acc[ai][bj][m][0] + bv[bj][0]), g1 * sig4(acc[ai][bj][m][1] + bv[bj][1])); } }
    }
};
struct EpiUpA {
    static constexpr bool PERM = true; const bf16_t* PROJ; bf16_t* T;
    __device__ __forceinline__ void operator()(const AccT& acc, const pg8::Unit& u, int wr, int wc, int fr, int fq) const {
        const int row0 = u.pm * 256 + wr * 64 + fr, col0 = u.pn * 256 + wc * 32 + 8 * fq;
#pragma unroll
        for (int ai = 0; ai < 2; ++ai) { u32x4 gw[4][2];
#pragma unroll
            for (int m = 0; m < 4; ++m)
#pragma unroll
                for (int bj = 0; bj < 2; ++bj) gw[m][bj] = *(const u32x4*)(PROJ + (size_t)(row0 + ai * 128 + m * 16) * NPROJ + C_GA + col0 + bj * 128);
#pragma unroll
            for (int m = 0; m < 4; ++m)
#pragma unroll
                for (int bj = 0; bj < 2; ++bj) { f32x4 g0, g1; unpack8(gw[m][bj], g0, g1);
                    *(u32x4*)(T + (size_t)(row0 + ai * 128 + m * 16) * D + col0 + bj * 128) = pack8(sig4(g0) * acc[ai][bj][m][0], sig4(g1) * acc[ai][bj][m][1]); } }
    }
};
struct EpiUpB {
    static constexpr bool PERM = true; const bf16_t* PROJ; const bf16_t* T; bf16_t* O;
    __device__ __forceinline__ void operator()(const AccT& acc, const pg8::Unit& u, int wr, int wc, int fr, int fq) const {
        const int row0 = u.pm * 256 + wr * 64 + fr, col0 = u.pn * 256 + wc * 32 + 8 * fq;
#pragma unroll
        for (int ai = 0; ai < 2; ++ai) { u32x4 gw[4][2], tw[4][2];
#pragma unroll
            for (int m = 0; m < 4; ++m)
#pragma unroll
                for (int bj = 0; bj < 2; ++bj) { const int r = row0 + ai * 128 + m * 16; gw[m][bj] = *(const u32x4*)(PROJ + (size_t)r * NPROJ + C_GB + col0 + bj * 128); tw[m][bj] = *(const u32x4*)(T + (size_t)r * D + col0 + bj * 128); }
#pragma unroll
            for (int m = 0; m < 4; ++m)
#pragma unroll
                for (int bj = 0; bj < 2; ++bj) { f32x4 g0, g1, t0, t1; unpack8(gw[m][bj], g0, g1); unpack8(tw[m][bj], t0, t1);
                    *(u32x4*)(O + (size_t)(row0 + ai * 128 + m * 16) * D + col0 + bj * 128) = pack8(t0 + sig4(g0) * acc[ai][bj][m][0], t1 + sig4(g1) * acc[ai][bj][m][1]); } }
    }
};
struct EpiRes {
    static constexpr bool PERM = true; const float* xp; const float* xs; const bf16_t* X1; int mode; bf16_t* R;
    __device__ __forceinline__ void operator()(const AccT& acc, const pg8::Unit& u, int wr, int wc, int fr, int fq) const {
        const int row0 = u.pm * 256 + wr * 64 + fr, col0 = u.pn * 256 + wc * 32 + 8 * fq;
#pragma unroll
        for (int ai = 0; ai < 2; ++ai) { f32x4 b0[4][2], b1[4][2];
#pragma unroll
            for (int m = 0; m < 4; ++m) { const int r = row0 + ai * 128 + m * 16; const int rc = r < NREAL ? r : NREAL - 1;
#pragma unroll
                for (int bj = 0; bj < 2; ++bj) {
                    if (mode) unpack8(*(const u32x4*)(X1 + (size_t)rc * D + col0 + bj * 128), b0[m][bj], b1[m][bj]);
                    else { const float* b2 = (rc < ROW_S ? xp + (size_t)rc * D : xs + (size_t)(rc - ROW_S) * D) + col0 + bj * 128; b0[m][bj] = *(const f32x4*)b2; b1[m][bj] = *(const f32x4*)(b2 + 4); } } }
#pragma unroll
            for (int m = 0; m < 4; ++m) { const int r = row0 + ai * 128 + m * 16;
                if (r < NREAL) {
#pragma unroll
                    for (int bj = 0; bj < 2; ++bj) *(u32x4*)(R + (size_t)r * D + col0 + bj * 128) = pack8(ALPHA * b0[m][bj] + acc[ai][bj][m][0], ALPHA * b1[m][bj] + acc[ai][bj][m][1]); } } }
    }
};
struct EpiGU {
    static constexpr bool PERM = true; bf16_t* O;
    __device__ __forceinline__ void operator()(const AccT& acc, const pg8::Unit& u, int wr, int wc, int fr, int fq) const {
        const int row0 = u.pm * 256 + wr * 64 + fr, col0 = u.pn * 128 + wc * 32 + 8 * fq;
#pragma unroll
        for (int ai = 0; ai < 2; ++ai)
#pragma unroll
            for (int m = 0; m < 4; ++m) { const int r = row0 + ai * 128 + m * 16;
                const f32x4 g0 = acc[ai][0][m][0], g1 = acc[ai][0][m][1];
                const f32x4 o0 = g0 * sig4(g0) * acc[ai][1][m][0], o1 = g1 * sig4(g1) * acc[ai][1][m][1];
                *(u32x4*)(O + (size_t)r * DFF + col0) = pack8(o0, o1); }
    }
};

struct TDesc { const float* src; bf16_t* dst; int ld, ldd; };
__device__ __forceinline__ TDesc tile_desc(const Params& P, int t) {
    unsigned char* ws = P.ws; TDesc d; int tl, nkt;
    if (t < 2304) { tl = t; nkt = 16; const int kt = tl % nkt, nt = tl / nkt; const int n0 = nt * 64; d.ld = 9224; d.ldd = 2048;
        d.src = P.in[8] + (size_t)kt * 128 * d.ld + n0 + (n0 >= 5120 ? 8 : 0); d.dst = (bf16_t*)(ws + O_WINT) + (size_t)n0 * d.ldd + kt * 128; }
    else if (t < 2432) { tl = t - 2304; nkt = 8; const int kt = tl % nkt, nt = tl / nkt; d.ld = 1024; d.ldd = 1024;
        d.src = P.in[18] + (size_t)kt * 128 * d.ld + nt * 64; d.dst = (bf16_t*)(ws + O_WGLUT) + (size_t)nt * 64 * d.ldd + kt * 128; }
    else if (t < 2688) { tl = t - 2432; nkt = 8; const int kt = tl % nkt, nt = tl / nkt; d.ld = 2048; d.ldd = 1024;
        d.src = P.in[20] + (size_t)kt * 128 * d.ld + nt * 64; d.dst = (bf16_t*)(ws + O_WAT) + (size_t)nt * 64 * d.ldd + kt * 128; }
    else if (t < 2944) { tl = t - 2688; nkt = 8; const int kt = tl % nkt, nt = tl / nkt; d.ld = 2048; d.ldd = 1024;
        d.src = P.in[22] + (size_t)kt * 128 * d.ld + nt * 64; d.dst = (bf16_t*)(ws + O_WBT) + (size_t)nt * 64 * d.ldd + kt * 128; }
    else if (t < 3456) { tl = t - 2944; nkt = 16; const int kt = tl % nkt, nt = tl / nkt; d.ld = 2048; d.ldd = 2048;
        d.src = P.in[23] + (size_t)kt * 128 * d.ld + nt * 64; d.dst = (bf16_t*)(ws + O_WOUTT) + (size_t)nt * 64 * d.ldd + kt * 128; }
    else if (t < 6272) { tl = t - 3456; nkt = 16; const int kt = tl % nkt, nt = tl / nkt; d.ld = DFF; d.ldd = 2048;
        const int rp = nt * 64, pn = rp >> 8, half = (rp >> 7) & 1, idx = rp & 127;
        d.src = (half ? P.in[27] : P.in[26]) + (size_t)kt * 128 * d.ld + pn * 128 + idx; d.dst = (bf16_t*)(ws + O_WGUT) + (size_t)rp * d.ldd + kt * 128; }
    else { tl = t - 6272; nkt = 44; const int kt = tl % nkt, nt = tl / nkt; d.ld = 2048; d.ldd = DFF;
        d.src = P.in[28] + (size_t)kt * 128 * d.ld + nt * 64; d.dst = (bf16_t*)(ws + O_WDT) + (size_t)nt * 64 * d.ldd + kt * 128; }
    return d;
}
__device__ __forceinline__ void phase0(const Params& P, unsigned char* shm) {
    float* tile = (float*)shm;
    unsigned char* ws = P.ws;
    const int tid = threadIdx.x, lane = tid & 63, wave = tid >> 6;
    {
        const int r0 = tid >> 4, c4 = tid & 15;
        int t = blockIdx.x; f32x4 v[4]; TDesc d = tile_desc(P, t < 2304 ? t : 0);
        if (t < 2304) {
#pragma unroll
            for (int i = 0; i < 4; ++i) v[i] = *(const f32x4*)(d.src + (size_t)(r0 + 32 * i) * d.ld + c4 * 4); }
        while (t < 2304) {
            const int tn = t + gridDim.x; f32x4 vn[4]; TDesc dn = tile_desc(P, tn < 2304 ? tn : 0);
            if (tn < 2304) {
#pragma unroll
                for (int i = 0; i < 4; ++i) vn[i] = *(const f32x4*)(dn.src + (size_t)(r0 + 32 * i) * dn.ld + c4 * 4); }
#pragma unroll
            for (int i = 0; i < 4; ++i) { float* tp = tile + (r0 + 32 * i) * 65 + c4 * 4; tp[0] = v[i][0]; tp[1] = v[i][1]; tp[2] = v[i][2]; tp[3] = v[i][3]; }
            __syncthreads();
            { const int n = tid >> 3, kc = tid & 7; float x[16];
#pragma unroll
              for (int j = 0; j < 8; ++j) { x[j] = tile[(kc * 8 + j) * 65 + n]; x[8 + j] = tile[(64 + kc * 8 + j) * 65 + n]; }
              u32x4 w0, w1; w0.x = cvt_pk_bf16(x[0], x[1]); w0.y = cvt_pk_bf16(x[2], x[3]); w0.z = cvt_pk_bf16(x[4], x[5]); w0.w = cvt_pk_bf16(x[6], x[7]);
              w1.x = cvt_pk_bf16(x[8], x[9]); w1.y = cvt_pk_bf16(x[10], x[11]); w1.z = cvt_pk_bf16(x[12], x[13]); w1.w = cvt_pk_bf16(x[14], x[15]);
              bf16_t* dp = d.dst + (size_t)n * d.ldd + kc * 8; *(u32x4*)dp = w0; *(u32x4*)(dp + 64) = w1; }
            __syncthreads();
            t = tn; d = dn;
#pragma unroll
            for (int i = 0; i < 4; ++i) v[i] = vn[i];
        }
    }
    float* wgT = (float*)shm;
    for (int i = tid; i < 2048 * 2; i += 512) { const int k = i >> 1, hh = i & 1; const f32x4 v = *(const f32x4*)(P.in[8] + (size_t)k * 9224 + 5120 + hh * 4);
        wgT[(hh * 4 + 0) * 2048 + k] = v[0]; wgT[(hh * 4 + 1) * 2048 + k] = v[1]; wgT[(hh * 4 + 2) * 2048 + k] = v[2]; wgT[(hh * 4 + 3) * 2048 + k] = v[3]; }
    __syncthreads();
    bf16_t* XB = (bf16_t*)(ws + O_XB); float* gif = (float*)(ws + O_GIF);
    for (int row = blockIdx.x * 8 + wave; row < MP; row += gridDim.x * 8) {
        const float* xr = row < ROW_S ? P.in[0] + (size_t)row * D : row < ROW_META ? P.in[1] + (size_t)(row - ROW_S) * D : row < ROW_META + 16 ? P.in[7] + (size_t)(row - ROW_META) * D : nullptr;
        float s[8];
#pragma unroll
        for (int q = 0; q < 8; ++q) s[q] = 0.f;
        f32x4 xv[8];
#pragma unroll
        for (int i = 0; i < 8; ++i) { xv[i] = (f32x4){0.f, 0.f, 0.f, 0.f}; if (xr) xv[i] = __builtin_nontemporal_load((const f32x4*)(xr + lane * 4 + 256 * i)); }
#pragma unroll
        for (int i = 0; i < 8; ++i) { const int k = lane * 4 + 256 * i; const f32x4 v = xv[i];
            u32x2 w; w.x = cvt_pk_bf16(v[0], v[1]); w.y = cvt_pk_bf16(v[2], v[3]); *(u32x2*)(XB + (size_t)row * D + k) = w;
#pragma unroll
            for (int q = 0; q < 8; ++q) { const f32x4 wv = *(const f32x4*)(wgT + q * 2048 + k); s[q] += v[0] * wv[0] + v[1] * wv[1] + v[2] * wv[2] + v[3] * wv[3]; }
            asm volatile("" ::: "memory"); }
#pragma unroll
        for (int q = 0; q < 8; ++q) s[q] = wave_sum(s[q]);
        if (lane == 0) {
#pragma unroll
            for (int q = 0; q < 8; ++q) gif[(size_t)row * 8 + q] = xr ? s[q] + P.in[9][q] : 0.f; }
    }
    __syncthreads();
}

__device__ __forceinline__ void convert_dynamic(const Params& P, unsigned char* shm, unsigned* ctr, int t0, int t1) {
    float* tile = (float*)shm; volatile int* sh_t = (volatile int*)(shm + 36864);
    const int tid = threadIdx.x, r0 = tid >> 4, c4 = tid & 15;
    for (;;) {
        if (tid == 0) *sh_t = t0 + 4 * (int)__hip_atomic_fetch_add(ctr, 1u, __ATOMIC_RELAXED, __HIP_MEMORY_SCOPE_AGENT);
        __syncthreads();
        const int t = *sh_t;
        if (t >= t1) break;
        TDesc d[4]; f32x4 v[4][4];
#pragma unroll
        for (int h = 0; h < 4; ++h) { d[h] = tile_desc(P, t + h < t1 ? t + h : t);
#pragma unroll
            for (int i = 0; i < 4; ++i) v[h][i] = *(const f32x4*)(d[h].src + (size_t)(r0 + 32 * i) * d[h].ld + c4 * 4); }
#pragma unroll
        for (int h = 0; h < 4; ++h) {
            if (t + h < t1) {
#pragma unroll
                for (int i = 0; i < 4; ++i) { float* tp = tile + (r0 + 32 * i) * 65 + c4 * 4; tp[0] = v[h][i][0]; tp[1] = v[h][i][1]; tp[2] = v[h][i][2]; tp[3] = v[h][i][3]; }
                __syncthreads();
                { const int n = tid >> 3, kc = tid & 7; float x[16];
#pragma unroll
                  for (int jj = 0; jj < 8; ++jj) { x[jj] = tile[(kc * 8 + jj) * 65 + n]; x[8 + jj] = tile[(64 + kc * 8 + jj) * 65 + n]; }
                  u32x4 w0, w1; w0.x = cvt_pk_bf16(x[0], x[1]); w0.y = cvt_pk_bf16(x[2], x[3]); w0.z = cvt_pk_bf16(x[4], x[5]); w0.w = cvt_pk_bf16(x[6], x[7]);
                  w1.x = cvt_pk_bf16(x[8], x[9]); w1.y = cvt_pk_bf16(x[10], x[11]); w1.z = cvt_pk_bf16(x[12], x[13]); w1.w = cvt_pk_bf16(x[14], x[15]);
                  bf16_t* dp = d[h].dst + (size_t)n * d[h].ldd + kc * 8; *(u32x4*)dp = w0; *(u32x4*)(dp + 64) = w1; }
                __syncthreads();
            }
        }
    }
    __syncthreads();
}

__device__ __forceinline__ void gate_chain(const float* gif, int b, int h, int j, float* sm) {
    const int tid = threadIdx.x, lane = tid & 63, wave = tid >> 6;
    for (int i = wave; i <= j; i += 8) {
        const int Li = i == 0 ? 16 : 128; const int rowb = i == 0 ? ROW_META : b * 2048 + (i - 1) * 128;
        const int t0 = 2 * lane;
        float f0 = 0.f, f1 = 0.f, i0 = -INFINITY, i1 = -INFINITY;
        if (t0 < Li) { const float* gp = gif + (size_t)(rowb + t0) * 8; i0 = gp[h]; f0 = logsig(gp[4 + h]); i1 = gp[8 + h]; f1 = logsig(gp[12 + h]); }
        const float s = f0 + f1; const float incl = wave_incl_scan(s, lane); const float excl = incl - s;
        const float b0 = excl + f0, b1 = incl;
        const float a0 = i0 - b0, a1 = i1 - b1;
        const float amax = wave_max(fmaxf(a0, a1)); const float btot = __shfl(incl, 63);
        if (lane == 0) { sm[256 + i] = btot; sm[288 + i] = amax; }
        if (i == j) { sm[t0] = a0; sm[t0 + 1] = a1; sm[128 + t0] = b0; sm[128 + t0 + 1] = b1; }
    }
    __syncthreads();
    if (tid == 0) { float m = 0.f; for (int i = 0; i < j; ++i) m = sm[256 + i] + fmaxf(m, sm[288 + i]); sm[320] = m; }
    __syncthreads();
}

__device__ __forceinline__ void gate_chain_gst(const float* gif, const float* gst, int bh, int j, float* sm) {
    const int tid = threadIdx.x, lane = tid & 63, wave = tid >> 6; const int b = bh >> 2, h = bh & 3;
    if (wave == 0) {
        const int rowb = b * 2048 + (j - 1) * 128; const int t0 = 2 * lane;
        const float* gp = gif + (size_t)(rowb + t0) * 8; const float i0 = gp[h], f0 = logsig(gp[4 + h]), i1 = gp[8 + h], f1 = logsig(gp[12 + h]);
        const float s = f0 + f1; const float incl = wave_incl_scan(s, lane); const float excl = incl - s;
        const float b0 = excl + f0, b1 = incl;
        sm[t0] = i0 - b0; sm[t0 + 1] = i1 - b1; sm[128 + t0] = b0; sm[128 + t0 + 1] = b1;
    } else if (wave == 1 && lane < j) { sm[256 + lane] = gst[(bh * 17 + lane) * 2]; sm[288 + lane] = gst[(bh * 17 + lane) * 2 + 1]; }
    __syncthreads();
    if (tid == 0) { float m = 0.f; for (int i = 0; i < j; ++i) m = sm[256 + i] + fmaxf(m, sm[288 + i]); sm[320] = m; }
    __syncthreads();
}

__device__ __forceinline__ void mlstm_local(const Params& P, unsigned char* shm, int bh, int j) {
    const int tid = threadIdx.x, lane = tid & 63, wave = tid >> 6, l16 = lane & 15, q = lane >> 4;
    const int b = bh >> 2, h = bh & 3;
    bf16_t* Kt = (bf16_t*)shm; bf16_t* Vt = (bf16_t*)(shm + 69632); float* sm = (float*)(shm + SM_OFF);
    const float* gif = (const float*)(P.ws + O_GIF); const bf16_t* PROJ = (const bf16_t*)(P.ws + O_PROJ);
    gate_chain(gif, b, h, j, sm);
    const float m_in = sm[320]; const float Ml = fmaxf(m_in, sm[288 + j]);
    if (tid == 0) { float* gst = (float*)(P.ws + O_GST); gst[(bh * 17 + j) * 2] = sm[256 + j]; gst[(bh * 17 + j) * 2 + 1] = sm[288 + j]; }
    const int L = j == 0 ? 16 : 128; const int rowb = j == 0 ? ROW_META : b * 2048 + (j - 1) * 128;
    const int niter = j == 0 ? 2 : 8;
#pragma unroll 2
    for (int i = 0; i < niter; ++i) { const int item = tid + 512 * i; const int s = ((item >> 9) << 4) | (item & 15), c8 = (item >> 4) & 31;
        u32x4 kw = (u32x4){0u, 0u, 0u, 0u}, vw = (u32x4){0u, 0u, 0u, 0u}; float w = 0.f;
        if (s < L) { const bf16_t* rp = PROJ + (size_t)(rowb + s) * NPROJ + h * 256 + c8 * 8; kw = *(const u32x4*)(rp + C_K); vw = *(const u32x4*)(rp + C_V); w = __expf(sm[s] - Ml) * 0.0625f; }
        f32x4 k0, k1; unpack8(kw, k0, k1);
        bf16_t* kd = Kt + (size_t)(c8 * 8) * 136 + s; bf16_t* vd = Vt + (size_t)(c8 * 8) * 136 + s;
        kd[0 * 136] = f2bf(k0[0] * w); kd[1 * 136] = f2bf(k0[1] * w); kd[2 * 136] = f2bf(k0[2] * w); kd[3 * 136] = f2bf(k0[3] * w);
        kd[4 * 136] = f2bf(k1[0] * w); kd[5 * 136] = f2bf(k1[1] * w); kd[6 * 136] = f2bf(k1[2] * w); kd[7 * 136] = f2bf(k1[3] * w);
        vd[0 * 136] = (bf16_t)(vw.x & 0xffffu); vd[1 * 136] = (bf16_t)(vw.x >> 16); vd[2 * 136] = (bf16_t)(vw.y & 0xffffu); vd[3 * 136] = (bf16_t)(vw.y >> 16);
        vd[4 * 136] = (bf16_t)(vw.z & 0xffffu); vd[5 * 136] = (bf16_t)(vw.z >> 16); vd[6 * 136] = (bf16_t)(vw.w & 0xffffu); vd[7 * 136] = (bf16_t)(vw.w >> 16); }
    __syncthreads();
    const int nks = j == 0 ? 1 : 4;
    float* LOCT = (float*)(P.ws + O_LOCT) + (size_t)(bh * 17 + j) * 65536;
#pragma unroll 1
    for (int nh = 0; nh < 2; ++nh) {
        f32x4 acc[2][8];
#pragma unroll
        for (int m = 0; m < 2; ++m)
#pragma unroll
            for (int n = 0; n < 8; ++n) acc[m][n] = (f32x4){0.f, 0.f, 0.f, 0.f};
#pragma unroll 1
        for (int ks = 0; ks < nks; ++ks) {
            const bf16x8 a0 = *(const bf16x8*)(Vt + (size_t)(32 * wave + l16) * 136 + 32 * ks + 8 * q);
            const bf16x8 a1 = *(const bf16x8*)(Vt + (size_t)(32 * wave + 16 + l16) * 136 + 32 * ks + 8 * q);
#pragma unroll
            for (int n = 0; n < 8; ++n) { const bf16x8 bb = *(const bf16x8*)(Kt + (size_t)(128 * nh + 16 * n + l16) * 136 + 32 * ks + 8 * q);
                acc[0][n] = mfma16(a0, bb, acc[0][n]); acc[1][n] = mfma16(a1, bb, acc[1][n]); }
        }
        MFMA_SETTLE();
#pragma unroll
        for (int m = 0; m < 2; ++m)
#pragma unroll
            for (int r = 0; r < 4; ++r) { float* rp = LOCT + (size_t)(32 * wave + 16 * m + 4 * q + r) * 256 + 128 * nh + l16;
#pragma unroll
                for (int n = 0; n < 8; ++n) rp[16 * n] = acc[m][n][r]; }
    }
    if (tid < 256) { float s = 0.f; const u32x4* kp = (const u32x4*)(Kt + (size_t)tid * 136);
        for (int i = 0; i < (j == 0 ? 4 : 16); ++i) { const u32x4 w = kp[i]; s += bflo(w.x) + bfhi(w.x) + bflo(w.y) + bfhi(w.y) + bflo(w.z) + bfhi(w.z) + bflo(w.w) + bfhi(w.w); }
        ((float*)(P.ws + O_NLOC))[(bh * 17 + j) * 256 + tid] = s; }
    __syncthreads();
}

__device__ __forceinline__ void mlstm_decode_wave(const Params& P, unsigned char* wl, int sh) {
    const int lane = threadIdx.x & 63; const int bs = sh >> 2, h = sh & 3, row = ROW_S + bs;
    float* sq = (float*)wl; float* sk = sq + 256;
    const float* gif = (const float*)(P.ws + O_GIF); const bf16_t* PROJ = (const bf16_t*)(P.ws + O_PROJ);
    const bf16_t* rp = PROJ + (size_t)row * NPROJ + h * 256 + 4 * lane;
    const u32x2 qw = *(const u32x2*)(rp + C_Q), kw = *(const u32x2*)(rp + C_K), vw = *(const u32x2*)(rp + C_V), ow = *(const u32x2*)(rp + C_O);
    const f32x4 q4 = (f32x4){bflo(qw.x), bfhi(qw.x), bflo(qw.y), bfhi(qw.y)};
    const f32x4 k4 = (f32x4){bflo(kw.x), bfhi(kw.x), bflo(kw.y), bfhi(kw.y)} * 0.0625f;
    const f32x4 v4 = (f32x4){bflo(vw.x), bfhi(vw.x), bflo(vw.y), bfhi(vw.y)};
    const f32x4 o4 = (f32x4){bflo(ow.x), bfhi(ow.x), bflo(ow.y), bfhi(ow.y)};
    const f32x4 n4 = *(const f32x4*)(P.in[5] + (size_t)sh * 256 + 4 * lane);
    *(f32x4*)(sq + 4 * lane) = q4; *(f32x4*)(sk + 4 * lane) = k4;
    const float ig = gif[(size_t)row * 8 + h], fl = logsig(gif[(size_t)row * 8 + 4 + h]), m0 = P.in[6][sh];
    const float mt = fmaxf(fl + m0, ig), wi = __expf(ig - mt), wc = __expf(fl + m0 - mt);
    const float qk = wave_sum(q4[0] * k4[0] + q4[1] * k4[1] + q4[2] * k4[2] + q4[3] * k4[3]);
    const float qn = wave_sum(q4[0] * n4[0] + q4[1] * n4[1] + q4[2] * n4[2] + q4[3] * n4[3]);
    asm volatile("s_waitcnt lgkmcnt(0)" ::: "memory");
    const float* C0 = P.in[4] + (size_t)sh * 65536 + 4 * lane; float* C1 = P.out + OUT_SC + (size_t)sh * 65536 + 4 * lane;
    f32x4 part = (f32x4){0.f, 0.f, 0.f, 0.f}; const f32x4 wv = wi * v4;
#pragma unroll 1
    for (int dk0 = 0; dk0 < 256; dk0 += 32) { f32x4 c[32];
#pragma unroll
        for (int i = 0; i < 32; ++i) c[i] = __builtin_nontemporal_load((const f32x4*)(C0 + (dk0 + i) * 256));
#pragma unroll
        for (int i = 0; i < 32; ++i) { const float qd = sq[dk0 + i], kd = sk[dk0 + i]; part += qd * c[i]; __builtin_nontemporal_store(wc * c[i] + kd * wv, (f32x4*)(C1 + (dk0 + i) * 256)); } }
    const float s = qk * wi; const f32x4 num = wc * part + s * v4; const float den = wc * qn + s;
    const float dinv = 1.0f / fmaxf(fabsf(den), __expf(-mt));
    f32x4 hv = num * dinv;
    const float mean = wave_sum((hv[0] + hv[1]) + (hv[2] + hv[3])) * (1.0f / 256.0f);
    hv -= mean;
    const float var = wave_sum((hv[0] * hv[0] + hv[1] * hv[1]) + (hv[2] * hv[2] + hv[3] * hv[3])) * (1.0f / 256.0f);
    const float rstd = rsqrtf(var + EPS);
    const f32x4 gn = *(const f32x4*)(P.in[21] + h * 256 + 4 * lane);
    const f32x4 y = sig4(o4) * hv * rstd * gn;
    u32x2 yw; yw.x = cvt_pk_bf16(y[0], y[1]); yw.y = cvt_pk_bf16(y[2], y[3]);
    *(u32x2*)((bf16_t*)(P.ws + O_YB) + (size_t)row * 1024 + h * 256 + 4 * lane) = yw;
    *(f32x4*)(P.out + OUT_SN + (size_t)sh * 256 + 4 * lane) = wc * n4 + wi * k4;
    if (lane == 0) P.out[OUT_SM + sh] = mt;
    asm volatile("s_waitcnt lgkmcnt(0)" ::: "memory");
}

__device__ __forceinline__ void mlstm_prefix(const Params& P) {
    const int gtid = blockIdx.x * 512 + threadIdx.x, nth = gridDim.x * 512;
    const float* gst = (const float*)(P.ws + O_GST); const float* LOCT = (const float*)(P.ws + O_LOCT); bf16_t* CTB = (bf16_t*)(P.ws + O_CTB);
    for (int item = gtid; item < 16 * 16384; item += nth) {
        const int bh = item >> 14, idx4 = (item & 16383) * 4;
        f32x4 C = (f32x4){0.f, 0.f, 0.f, 0.f}; float m = 0.f;
#pragma unroll
        for (int j = 0; j < 17; ++j) { const float bt = gst[(bh * 17 + j) * 2], am = gst[(bh * 17 + j) * 2 + 1]; const float Ml = fmaxf(m, am), carry = __expf(m - Ml);
            if (j >= 1) { u32x2 w; w.x = cvt_pk_bf16(C[0], C[1]); w.y = cvt_pk_bf16(C[2], C[3]); *(u32x2*)(CTB + (size_t)(bh * 16 + j - 1) * 65536 + idx4) = w; }
            const f32x4 loc = *(const f32x4*)(LOCT + (size_t)(bh * 17 + j) * 65536 + idx4); C = carry * C + loc; m = bt + Ml; }
        const int dv = idx4 >> 8, dk = idx4 & 255; float* pc = P.out + OUT_PC + (size_t)bh * 65536;
#pragma unroll
        for (int e = 0; e < 4; ++e) pc[(size_t)(dk + e) * 256 + dv] = C[e];
    }
    const float* NLOC = (const float*)(P.ws + O_NLOC); float* NJ = (float*)(P.ws + O_NJ);
    for (int item = gtid; item < 4096; item += nth) {
        const int bh = item >> 8, dk = item & 255; float n = 0.f, m = 0.f;
        for (int j = 0; j < 17; ++j) { const float bt = gst[(bh * 17 + j) * 2], am = gst[(bh * 17 + j) * 2 + 1]; const float Ml = fmaxf(m, am), carry = __expf(m - Ml);
            NJ[(bh * 17 + j) * 256 + dk] = n; n = carry * n + NLOC[(bh * 17 + j) * 256 + dk]; m = bt + Ml; }
        P.out[OUT_PN + (size_t)bh * 256 + dk] = n; if (dk == 0) P.out[OUT_PM + bh] = m;
    }
}

__device__ __forceinline__ void mlstm_out(const Params& P, unsigned char* shm, int bh, int j) {
    const int tid = threadIdx.x, lane = tid & 63, wave = tid >> 6, l16 = lane & 15, q = lane >> 4;
    const int b = bh >> 2, h = bh & 3; const int rowb = b * 2048 + (j - 1) * 128;
    bf16_t* Qs = (bf16_t*)shm; bf16_t* Ss = (bf16_t*)(shm + 67584); float* sm = (float*)(shm + SM_OFF);
    float* sMt = sm + 384; float* sWi = sm + 512; float* sFl = sm + 640; float* sDen = sm + 768; float* sRow = sm + 896; float* sLN = sm + 1408; float* sMu = sm + 2432; float* sRs = sm + 2560;
    const float* gif = (const float*)(P.ws + O_GIF); const bf16_t* PROJ = (const bf16_t*)(P.ws + O_PROJ);
    const bf16_t* PR = PROJ + (size_t)rowb * NPROJ + h * 256;
    gate_chain_gst(gif, (const float*)(P.ws + O_GST), bh, j, sm);
    const float m_in = sm[320];
    float* sNj = sm + 2688;
    if (tid < 128) {
        float M = sm[tid];
#pragma unroll
        for (int o = 1; o < 64; o <<= 1) { const float t = __shfl_up(M, o); if (lane >= o) M = fmaxf(M, t); }
        if (tid == 63) sm[321] = M;
        asm volatile("s_waitcnt lgkmcnt(0)" ::: "memory");
        sMt[tid] = M; }
    else if (tid < 384) sNj[tid - 128] = ((const float*)(P.ws + O_NJ))[(bh * 17 + j) * 256 + tid - 128];
    __syncthreads();
    if (tid < 128) { float M = sMt[tid]; if (tid >= 64) M = fmaxf(M, sm[321]); M = fmaxf(M, m_in); sMt[tid] = M; sWi[tid] = __expf(m_in - M); sFl[tid] = __expf(-(sm[128 + tid] + M)); }
    { const int r = tid >> 5, c8 = tid & 31; const bf16_t* src = PR + r * NPROJ + C_Q + c8 * 8; bf16_t* dst = Qs + r * 264 + c8 * 8;
#pragma unroll
      for (int i = 0; i < 8; ++i) *(u32x4*)(dst + i * 16 * 264) = *(const u32x4*)(src + i * 16 * NPROJ); }
    __syncthreads();
    {
        const int wr2 = wave >> 2, wc4 = wave & 3;
        f32x4 acc[4][2];
#pragma unroll
        for (int m = 0; m < 4; ++m) { acc[m][0] = (f32x4){0.f, 0.f, 0.f, 0.f}; acc[m][1] = (f32x4){0.f, 0.f, 0.f, 0.f}; }
        const bf16_t* kbase = PR + (32 * wc4 + l16) * NPROJ + C_K + 8 * q;
        const bf16_t* qbase = Qs + (64 * wr2 + l16) * 264 + 8 * q;
#pragma unroll 2
        for (int ks = 0; ks < 8; ++ks) {
            const bf16x8 kf0 = *(const bf16x8*)(kbase + 32 * ks), kf1 = *(const bf16x8*)(kbase + 16 * NPROJ + 32 * ks);
#pragma unroll
            for (int m = 0; m < 4; ++m) { const bf16x8 a = *(const bf16x8*)(qbase + 16 * m * 264 + 32 * ks);
                acc[m][0] = mfma16(a, kf0, acc[m][0]); acc[m][1] = mfma16(a, kf1, acc[m][1]); } }
        MFMA_SETTLE();
        const int tb = 64 * wr2 + 4 * q, sb = 32 * wc4 + l16;
        const float as0 = sm[sb], as1 = sm[sb + 16];
        const float* pMt = sMt + tb; bf16_t* pSs = Ss + tb * 136 + sb; float* pRow = sRow + wc4 * 128 + tb;
#pragma unroll
        for (int m = 0; m < 4; ++m)
#pragma unroll
            for (int r = 0; r < 4; ++r) { const int t = tb + 16 * m + r; const float Mt = pMt[16 * m + r];
                float v0 = 0.f, v1 = 0.f; if (sb <= t) v0 = acc[m][0][r] * 0.0625f * __expf(as0 - Mt); if (sb + 16 <= t) v1 = acc[m][1][r] * 0.0625f * __expf(as1 - Mt);
                const bf16_t b0 = f2bf(v0), b1 = f2bf(v1); pSs[(16 * m + r) * 136] = b0; pSs[(16 * m + r) * 136 + 16] = b1;
                float rs = bf2f(b0) + bf2f(b1);
                rs = row16_sum(rs);
                if (l16 == 0) pRow[16 * m + r] = rs; }
    }
    __syncthreads();
    {
        const int t = tid >> 2, part = tid & 3; const float* nj = sNj + part * 64; const bf16_t* qp = Qs + t * 264 + part * 64;
        float s = 0.f;
#pragma unroll 8
        for (int i = 0; i < 64; ++i) s += bf2f(qp[i]) * nj[i];
        s += __shfl_xor(s, 1); s += __shfl_xor(s, 2);
        if (part == 0) { const float den = sWi[t] * s + sRow[t] + sRow[128 + t] + sRow[256 + t] + sRow[384 + t]; sDen[t] = 1.0f / fmaxf(fabsf(den), sFl[t]); }
    }
    f32x4 acc[8][2];
#pragma unroll
    for (int m = 0; m < 8; ++m) { acc[m][0] = (f32x4){0.f, 0.f, 0.f, 0.f}; acc[m][1] = (f32x4){0.f, 0.f, 0.f, 0.f}; }
    {
        const bf16_t* cbase = (const bf16_t*)(P.ws + O_CTB) + (size_t)(bh * 16 + j - 1) * 65536 + (32 * wave + l16) * 256 + 8 * q;
        const bf16_t* qbase = Qs + l16 * 264 + 8 * q;
#pragma unroll 2
        for (int ks = 0; ks < 8; ++ks) { const bf16x8 cf0 = *(const bf16x8*)(cbase + 32 * ks), cf1 = *(const bf16x8*)(cbase + 16 * 256 + 32 * ks);
#pragma unroll
            for (int m = 0; m < 8; ++m) { const bf16x8 a = *(const bf16x8*)(qbase + 16 * m * 264 + 32 * ks);
                acc[m][0] = mfma16(a, cf0, acc[m][0]); acc[m][1] = mfma16(a, cf1, acc[m][1]); } }
        MFMA_SETTLE();
        const float* pWi = sWi + 4 * q;
#pragma unroll
        for (int m = 0; m < 8; ++m)
#pragma unroll
            for (int r = 0; r < 4; ++r) { const float w = pWi[16 * m + r]; acc[m][0][r] *= w; acc[m][1][r] *= w; }
    }
    unsigned opk[8][4];
    { const bf16_t* obase = PR + (4 * q) * NPROJ + C_O + 32 * wave + l16;
#pragma unroll
      for (int m = 0; m < 8; ++m)
#pragma unroll
          for (int r = 0; r < 4; ++r) opk[m][r] = (unsigned)obase[(16 * m + r) * NPROJ] | ((unsigned)obase[(16 * m + r) * NPROJ + 16] << 16); }
    {
        const bf16_t* sbase = Ss + l16 * 136 + 8 * q;
#pragma unroll 1
        for (int ks = 0; ks < 4; ++ks) { bf16x8 vf0, vf1;
            const bf16_t* vp = PR + (32 * ks + 8 * q) * NPROJ + C_V + 32 * wave + l16;
#pragma unroll
            for (int e = 0; e < 8; ++e) { vf0[e] = (short)vp[e * NPROJ]; vf1[e] = (short)vp[e * NPROJ + 16]; }
#pragma unroll
            for (int m = 0; m < 8; ++m) { const bf16x8 a = *(const bf16x8*)(sbase + 16 * m * 136 + 32 * ks);
                acc[m][0] = mfma16(a, vf0, acc[m][0]); acc[m][1] = mfma16(a, vf1, acc[m][1]); } }
        MFMA_SETTLE();
    }
    __syncthreads();
    { float* sLN2 = sm + 2944; const float* pDen = sDen + 4 * q; float* pLN = sLN + wave * 128 + 4 * q; float* pLN2 = sLN2 + wave * 128 + 4 * q;
#pragma unroll
    for (int m = 0; m < 8; ++m)
#pragma unroll
        for (int r = 0; r < 4; ++r) { const float di = pDen[16 * m + r]; acc[m][0][r] *= di; acc[m][1][r] *= di;
            const float s1 = row16_sum(acc[m][0][r] + acc[m][1][r]); const float s2 = row16_sum(acc[m][0][r] * acc[m][0][r] + acc[m][1][r] * acc[m][1][r]);
            if (l16 == 0) { pLN[16 * m + r] = s1; pLN2[16 * m + r] = s2; } }
    __syncthreads();
    if (tid < 128) { float s1 = 0.f, s2 = 0.f;
#pragma unroll
        for (int w = 0; w < 8; ++w) { s1 += sLN[w * 128 + tid]; s2 += sLN2[w * 128 + tid]; }
        const float mu = s1 * (1.0f / 256.0f); sMu[tid] = mu; sRs[tid] = rsqrtf(fmaxf(s2 * (1.0f / 256.0f) - mu * mu, 0.f) + EPS); }
    __syncthreads();
    { const float* pMu = sMu + 4 * q;
#pragma unroll
      for (int m = 0; m < 8; ++m)
#pragma unroll
          for (int r = 0; r < 4; ++r) { const float mu = pMu[16 * m + r]; acc[m][0][r] -= mu; acc[m][1][r] -= mu; } } }
    const int col0 = h * 256 + 32 * wave + l16; const float gain0 = P.in[21][col0], gain1 = P.in[21][col0 + 16];
    bf16_t* ybase = (bf16_t*)(P.ws + O_YB) + (size_t)(rowb + 4 * q) * 1024 + col0; const float* pRs = sRs + 4 * q;
#pragma unroll
    for (int m = 0; m < 8; ++m)
#pragma unroll
        for (int r = 0; r < 4; ++r) { const float rs = pRs[16 * m + r]; const float o0 = bflo(opk[m][r]), o1 = bfhi(opk[m][r]);
            ybase[(16 * m + r) * 1024] = f2bf(sigmoidf_(o0) * acc[m][0][r] * rs * gain0); ybase[(16 * m + r) * 1024 + 16] = f2bf(sigmoidf_(o1) * acc[m][1][r] * rs * gain1); }
    __syncthreads();
}

__device__ __forceinline__ void s5_setup(const Params& P, int g, int p, float& ar, float& ai, float (&Br)[16], float (&Bi)[16]) {
    const int gp = g * 64 + p;
    const float lre = P.in[10][gp], lim = P.in[11][gp], dt = expf(P.in[12][gp]);
    const float zr = lre * dt, zi = lim * dt; const float er = expf(zr); float sn, cs; sincosf(zi, &sn, &cs);
    ar = er * cs; ai = er * sn;
    const float nr = ar - 1.0f, ni = ai, den = 1.0f / (lre * lre + lim * lim);
    const float cr = (nr * lre + ni * lim) * den, ci = (ni * lre - nr * lim) * den;
    const f32x4* bre = (const f32x4*)(P.in[13] + (size_t)gp * 16); const f32x4* bim = (const f32x4*)(P.in[14] + (size_t)gp * 16);
#pragma unroll
    for (int c4 = 0; c4 < 4; ++c4) { const f32x4 x = bre[c4], y = bim[c4];
#pragma unroll
        for (int e = 0; e < 4; ++e) { Br[c4 * 4 + e] = cr * x[e] - ci * y[e]; Bi[c4 * 4 + e] = cr * y[e] + ci * x[e]; } }
}
constexpr int S5_WL = 16896;
template <int MODE>
__device__ __forceinline__ void s5_unit(const Params& P, unsigned char* wl, const int id) {
    const int lane = threadIdx.x & 63, l16 = lane & 15, q = lane >> 4;
    bf16_t* Btab = (bf16_t*)wl; float* buf = (float*)(wl + 4096); unsigned* Hw = (unsigned*)(wl + 4096 + 8320); bf16_t* Ub = Btab;
    const bf16_t* PROJ = (const bf16_t*)(P.ws + O_PROJ); bf16_t* G = (bf16_t*)(P.ws + O_G);
    int g, row0, nblk, slot = 0, b = 0, c = 0, sb = 0;
    if (MODE == 0) { if (id < 3840) { g = id & 63; c = (id >> 6) % 15; b = id / 960; row0 = b * 2048 + c * 128; nblk = 8; slot = b * 16 + c; } else { g = id - 3840; row0 = ROW_META; nblk = 1; slot = 64; } }
    else if (MODE == 1) { g = id & 63; c = (id >> 6) & 15; b = id >> 10; row0 = b * 2048 + c * 128; nblk = 8; }
    else { g = id & 63; sb = id >> 6; row0 = ROW_S + sb * 16; nblk = 1; }
    float ar, ai; float Br[16], Bi[16];
    { s5_setup(P, g, lane, ar, ai, Br, Bi);
      u32x4 w[4], v[4];
#pragma unroll
      for (int i = 0; i < 4; ++i) { unsigned hw[4], lw[4];
#pragma unroll
          for (int e = 0; e < 4; ++e) { const int c0 = (i & 1) * 8 + 2 * e; const float x0 = (i < 2) ? Br[c0] : Bi[c0], x1 = (i < 2) ? Br[c0 + 1] : Bi[c0 + 1];
              const unsigned h = cvt_pk_bf16(x0, x1); hw[e] = h; lw[e] = cvt_pk_bf16(x0 - bflo(h), x1 - bfhi(h)); }
          w[i] = (u32x4){hw[0], hw[1], hw[2], hw[3]}; v[i] = (u32x4){lw[0], lw[1], lw[2], lw[3]}; }
      u32x4* bt = (u32x4*)(Btab + lane * 32); bt[0] = w[0]; bt[1] = w[1]; bt[2] = w[2]; bt[3] = w[3];
      u32x4* lt = (u32x4*)((bf16_t*)buf + lane * 32); lt[0] = v[0]; lt[1] = v[1]; lt[2] = v[2]; lt[3] = v[3]; }
    asm volatile("s_waitcnt lgkmcnt(0)" ::: "memory");
    const bf16x8 zf = (bf16x8){0, 0, 0, 0, 0, 0, 0, 0};
    bf16x8 bfr[8];
#pragma unroll
    for (int nn = 0; nn < 8; ++nn) bfr[nn] = *(const bf16x8*)((q < 2 ? Btab : (const bf16_t*)buf) + (16 * nn + l16) * 16 + 8 * (q & 1));
    asm volatile("s_waitcnt lgkmcnt(0)" ::: "memory");
    float hr = 0.f, hi = 0.f;
    if (MODE == 1) { float pr = ar, pi = ai;
#pragma unroll
        for (int i = 0; i < 7; ++i) { const float t = pr * pr - pi * pi; pi = 2.0f * pr * pi; pr = t; }
        const f32x2* E = (const f32x2*)(P.ws + O_ESSM);
        { const f32x2 e = E[(size_t)(64 * 64 + g) * 64 + lane]; hr = e.x; hi = e.y; }
        for (int i = 0; i < c; ++i) { const f32x2 e = E[(size_t)((b * 16 + i) * 64 + g) * 64 + lane]; const float nr_ = pr * hr - pi * hi + e.x, ni_ = pr * hi + pi * hr + e.y; hr = nr_; hi = ni_; } }
    bf16x8 cf[4]; float dsk = 0.f;
    if (MODE >= 1) {
#pragma unroll
        for (int ks = 0; ks < 4; ++ks) { const int p0 = 16 * ks + 4 * q; const f32x4 cr = *(const f32x4*)(P.in[15] + (size_t)(g * 16 + l16) * 64 + p0), ci = *(const f32x4*)(P.in[16] + (size_t)(g * 16 + l16) * 64 + p0);
            bf16x8 f; f[0] = (short)f2bf(cr[0]); f[1] = (short)f2bf(-ci[0]); f[2] = (short)f2bf(cr[1]); f[3] = (short)f2bf(-ci[1]); f[4] = (short)f2bf(cr[2]); f[5] = (short)f2bf(-ci[2]); f[6] = (short)f2bf(cr[3]); f[7] = (short)f2bf(-ci[3]); cf[ks] = f; }
        dsk = P.in[17][g * 16 + l16]; }
    const bf16_t* arow = PROJ + (size_t)(row0 + l16) * NPROJ + C_U + g * 16 + 8 * (q & 1);
    bf16x8 a_cur = *(const bf16x8*)arow;
    for (int blk = 0; blk < nblk; ++blk) {
        bf16x8 a_nxt = zf; if (blk + 1 < nblk) a_nxt = *(const bf16x8*)(arow + (size_t)(blk + 1) * 16 * NPROJ);
        { float* bp = buf + (4 * q) * 130 + l16; f32x4 d[8];
#pragma unroll
          for (int nn = 0; nn < 8; ++nn) d[nn] = mfma16(a_cur, bfr[nn], (f32x4){0.f, 0.f, 0.f, 0.f});
          __builtin_amdgcn_sched_barrier(0); asm volatile("s_nop 15\n\ts_nop 15" ::: "memory"); __builtin_amdgcn_sched_barrier(0);
#pragma unroll
          for (int nn = 0; nn < 8; ++nn) { bp[16 * nn] = d[nn][0]; bp[130 + 16 * nn] = d[nn][1]; bp[260 + 16 * nn] = d[nn][2]; bp[390 + 16 * nn] = d[nn][3]; } }
        if (MODE >= 1 && q < 2) *(bf16x8*)(Ub + l16 * 16 + 8 * q) = a_cur;
        asm volatile("s_waitcnt lgkmcnt(0)" ::: "memory");
#ifdef S5_DIAG
        if (MODE == 1) { float mxd = 0.f, mxa = 0.f;
        for (int t = 0; t < 16; ++t) { const u32x4* upp = (const u32x4*)(PROJ + (size_t)(row0 + blk * 16 + t) * NPROJ + C_U + g * 16); f32x4 ua, ub, uc, ud; unpack8(upp[0], ua, ub); unpack8(upp[1], uc, ud);
            float br = 0.f, bi = 0.f;
#pragma unroll
            for (int e = 0; e < 4; ++e) { br += Br[e] * ua[e] + Br[4 + e] * ub[e] + Br[8 + e] * uc[e] + Br[12 + e] * ud[e]; bi += Bi[e] * ua[e] + Bi[4 + e] * ub[e] + Bi[8 + e] * uc[e] + Bi[12 + e] * ud[e]; }
            const f32x2 mm = *(const f32x2*)(buf + t * 130 + 2 * lane);
            mxd = fmaxf(mxd, fmaxf(fabsf(mm.x - br), fabsf(mm.y - bi))); mxa = fmaxf(mxa, fmaxf(fabsf(br), fabsf(bi))); }
        mxd = wave_max(mxd); mxa = wave_max(mxa);
        if (lane == 0) { atomicMax((unsigned*)(P.ws + O_BAR) + 0, __float_as_uint(mxd)); atomicMax((unsigned*)(P.ws + O_BAR) + 1, __float_as_uint(mxa)); } }
#endif
#ifdef S5_EXACT
        for (int t = 0; t < 16; ++t) { const u32x4* upp = (const u32x4*)(PROJ + (size_t)(row0 + blk * 16 + t) * NPROJ + C_U + g * 16); f32x4 ua, ub, uc, ud; unpack8(upp[0], ua, ub); unpack8(upp[1], uc, ud);
            float br = 0.f, bi = 0.f;
#pragma unroll
            for (int e = 0; e < 4; ++e) { br += Br[e] * ua[e] + Br[4 + e] * ub[e] + Br[8 + e] * uc[e] + Br[12 + e] * ud[e]; bi += Bi[e] * ua[e] + Bi[4 + e] * ub[e] + Bi[8 + e] * uc[e] + Bi[12 + e] * ud[e]; }
            *(f32x2*)(buf + t * 130 + 2 * lane) = (f32x2){br, bi}; }
        asm volatile("s_waitcnt lgkmcnt(0)" ::: "memory");
#endif
        if (MODE == 2) {
#pragma unroll
            for (int t = 0; t < 16; ++t) { const size_t si = (size_t)((sb * 16 + t) * 64 + g) * 64 + lane; const float h0r = P.in[2][si], h0i = P.in[3][si];
                const f32x2 bb = *(const f32x2*)(buf + t * 130 + 2 * lane);
                const float nr_ = ar * h0r - ai * h0i + bb.x, ni_ = ar * h0i + ai * h0r + bb.y; P.out[OUT_SRE + si] = nr_; P.out[OUT_SIM + si] = ni_; Hw[t * 68 + lane] = cvt_pk_bf16(nr_, ni_); }
        } else {
            f32x2 bb[16];
#pragma unroll
            for (int t = 0; t < 16; ++t) bb[t] = *(const f32x2*)(buf + t * 130 + 2 * lane);
#pragma unroll
            for (int t = 0; t < 16; ++t) { const float nr_ = ar * hr - ai * hi + bb[t].x, ni_ = ar * hi + ai * hr + bb[t].y; hr = nr_; hi = ni_;
                if (MODE == 1) Hw[t * 68 + lane] = cvt_pk_bf16(hr, hi); }
        }
        if (MODE >= 1) {
            asm volatile("s_waitcnt lgkmcnt(0)" ::: "memory");
            f32x4 acc = (f32x4){0.f, 0.f, 0.f, 0.f};
#pragma unroll
            for (int ks = 0; ks < 4; ++ks) acc = mfma16(*(const bf16x8*)((const bf16_t*)Hw + l16 * 136 + 32 * ks + 8 * q), cf[ks], acc);
            __builtin_amdgcn_sched_barrier(0); asm volatile("s_nop 15\n\ts_nop 15" : "+v"(acc) :: "memory"); __builtin_amdgcn_sched_barrier(0);
            const bf16_t* up = Ub + (4 * q) * 16 + l16; bf16_t* gp = G + (size_t)(row0 + blk * 16 + 4 * q) * 1024 + g * 16 + l16;
#pragma unroll
            for (int r = 0; r < 4; ++r) { const float y = acc[r] + dsk * bf2f(up[r * 16]); gp[r * 1024] = f2bf(gelu_tanh(y)); }
        }
        asm volatile("s_waitcnt lgkmcnt(0)" ::: "memory");
        a_cur = a_nxt;
    }
    if (MODE == 0) ((f32x2*)(P.ws + O_ESSM))[(size_t)(slot * 64 + g) * 64 + lane] = (f32x2){hr, hi};
    if (MODE == 1 && c == 15) { P.out[OUT_PRE + (size_t)(b * 64 + g) * 64 + lane] = hr; P.out[OUT_PIM + (size_t)(b * 64 + g) * 64 + lane] = hi; }
}

template <int MODE>
__device__ __forceinline__ void skinny_phase(const Params& P, unsigned char* shm) {
    const int tid = threadIdx.x, lane = tid & 63, wave = tid >> 6, l16 = lane & 15, q = lane >> 4;
    float* red = (float*)shm;
    unsigned char* ws = P.ws;
    for (int tile = blockIdx.x; tile < 256; tile += gridDim.x) {
        const int mt = tile & 3, nt = tile >> 2;
        const bf16_t* A; const bf16_t* Bt; int ld, k0, nks;
        if (MODE == 0) { const int half = wave >> 2; A = (const bf16_t*)(ws + (half ? O_YB : O_YA)); Bt = (const bf16_t*)(ws + (half ? O_WBT : O_WAT)); ld = 1024; nks = 8; k0 = (wave & 3) * 256; }
        else if (MODE == 1) { A = (const bf16_t*)(ws + O_MIX); Bt = (const bf16_t*)(ws + O_WOUTT); ld = 2048; nks = 8; k0 = wave * 256; }
        else { A = (const bf16_t*)(ws + O_HFF); Bt = (const bf16_t*)(ws + O_WDT); ld = DFF; nks = 22; k0 = wave * 704; }
        const bf16_t* ap = A + (size_t)(ROW_S + 32 * mt + l16) * ld + k0 + 8 * q; const bf16_t* bp = Bt + (size_t)(32 * nt + l16) * ld + k0 + 8 * q;
        f32x4 acc[2][2];
#pragma unroll
        for (int i = 0; i < 2; ++i) { acc[i][0] = (f32x4){0.f, 0.f, 0.f, 0.f}; acc[i][1] = (f32x4){0.f, 0.f, 0.f, 0.f}; }
#pragma unroll 8
        for (int ks = 0; ks < nks; ++ks) { const bf16x8 a0 = *(const bf16x8*)(ap + 32 * ks), a1 = *(const bf16x8*)(ap + (size_t)16 * ld + 32 * ks), b0 = *(const bf16x8*)(bp + 32 * ks), b1 = *(const bf16x8*)(bp + (size_t)16 * ld + 32 * ks);
            acc[0][0] = mfma16(a0, b0, acc[0][0]); acc[0][1] = mfma16(a0, b1, acc[0][1]); acc[1][0] = mfma16(a1, b0, acc[1][0]); acc[1][1] = mfma16(a1, b1, acc[1][1]); }
        MFMA_SETTLE();
#pragma unroll
        for (int mi = 0; mi < 2; ++mi)
#pragma unroll
            for (int ni = 0; ni < 2; ++ni)
#pragma unroll
                for (int r = 0; r < 4; ++r) red[wave * 1024 + (16 * mi + 4 * q + r) * 32 + 16 * ni + l16] = acc[mi][ni][r];
        __syncthreads();
        { const int e = tid * 2, rr = e >> 5, cc = e & 31; const int row = ROW_S + 32 * mt + rr, col = 32 * nt + cc;
          float s0 = 0.f, s1 = 0.f, u0 = 0.f, u1 = 0.f;
#pragma unroll
          for (int w = 0; w < 4; ++w) { const f32x2 x = *(const f32x2*)(red + w * 1024 + e), y = *(const f32x2*)(red + (4 + w) * 1024 + e); s0 += x.x; s1 += x.y; u0 += y.x; u1 += y.y; }
          if (MODE == 0) { const bf16_t* gp = (const bf16_t*)(ws + O_PROJ) + (size_t)row * NPROJ + col;
              const unsigned ga = *(const unsigned*)(gp + C_GA), gb = *(const unsigned*)(gp + C_GB);
              const float m0 = sigmoidf_(bflo(ga)) * s0 + sigmoidf_(bflo(gb)) * u0, m1 = sigmoidf_(bfhi(ga)) * s1 + sigmoidf_(bfhi(gb)) * u1;
              *(unsigned*)((bf16_t*)(ws + O_MIX) + (size_t)row * D + col) = cvt_pk_bf16(m0, m1); }
          else if (MODE == 1) { const f32x2 xv = *(const f32x2*)(P.in[1] + (size_t)(row - ROW_S) * D + col);
              *(unsigned*)((bf16_t*)(ws + O_R) + (size_t)row * D + col) = cvt_pk_bf16(ALPHA * xv.x + s0 + u0, ALPHA * xv.y + s1 + u1); }
          else { const unsigned xw = *(const unsigned*)((const bf16_t*)(ws + O_X1B) + (size_t)row * D + col);
              *(unsigned*)((bf16_t*)(ws + O_R) + (size_t)row * D + col) = cvt_pk_bf16(ALPHA * bflo(xw) + s0 + u0, ALPHA * bfhi(xw) + s1 + u1); } }
        __syncthreads();
    }
}

__device__ __forceinline__ void ln_pass(const Params& P, const bf16_t* R, const float* gam, const float* bet, int mode) {
    const int lane = threadIdx.x & 63, wave = threadIdx.x >> 6;
    for (int row = blockIdx.x * 8 + wave; row < NREAL; row += gridDim.x * 8) {
        const bf16_t* rp = R + (size_t)row * D; f32x4 v[8]; float s = 0.f;
#pragma unroll
        for (int i = 0; i < 4; ++i) { unpack8(*(const u32x4*)(rp + lane * 8 + 512 * i), v[2 * i], v[2 * i + 1]); }
#pragma unroll
        for (int i = 0; i < 8; ++i) s += (v[i][0] + v[i][1]) + (v[i][2] + v[i][3]);
        const float mu = wave_sum(s) * (1.0f / D); float qv = 0.f;
#pragma unroll
        for (int i = 0; i < 8; ++i) { v[i] -= mu; qv += (v[i][0] * v[i][0] + v[i][1] * v[i][1]) + (v[i][2] * v[i][2] + v[i][3] * v[i][3]); }
        float rstd = rsqrtf(wave_sum(qv) * (1.0f / D) + EPS);
        float* op = row < ROW_S ? P.out + OUT_YP + (size_t)row * D : P.out + OUT_YS + (size_t)(row - ROW_S) * D;
#pragma unroll
        for (int i = 0; i < 4; ++i) { const int k = lane * 8 + 512 * i;
            const f32x4 o0 = v[2 * i] * rstd * *(const f32x4*)(gam + k) + *(const f32x4*)(bet + k), o1 = v[2 * i + 1] * rstd * *(const f32x4*)(gam + k + 4) + *(const f32x4*)(bet + k + 4);
            if (mode == 0) *(u32x4*)((bf16_t*)(P.ws + O_X1B) + (size_t)row * D + k) = pack8(o0, o1);
            else { *(f32x4*)(op + k) = o0; *(f32x4*)(op + k + 4) = o1; } }
    }
}

#define XB_TMO      128
#define XB_XCNT(j)  (256  + 64 * (j))
#define XB_XSUB(j)  (1280 + 64 * (j))
#define XB_XGEN(j)  (2304 + 64 * (j))
#define XB_TOP      3328
#define XB_TOPGEN   3392
#define XCD_BAR_WORDS 3456
#define XB_SPIN_CAP (1u << 22)
__device__ __forceinline__ unsigned xb_ld(unsigned* p)              { return __hip_atomic_load(p, __ATOMIC_RELAXED, __HIP_MEMORY_SCOPE_AGENT); }
__device__ __forceinline__ unsigned xb_add(unsigned* p, unsigned v) { return __hip_atomic_fetch_add(p, v, __ATOMIC_RELAXED, __HIP_MEMORY_SCOPE_AGENT); }
__device__ __forceinline__ unsigned xb_xcc_id() { return (unsigned)__builtin_amdgcn_s_getreg((3 << 11) | 20) & 0xFu; }
#define XB_SPIN(cond, bar) do { unsigned _sp = 0; while (cond) { __builtin_amdgcn_s_sleep(1); \
    if ((++_sp & 255u) == 0u) { if (xb_ld(&(bar)[XB_TMO])) break; if (_sp > XB_SPIN_CAP) { atomicAdd(&(bar)[XB_TMO], 1u); break; } } } } while (0)
struct XcdBarrier { unsigned* bar; unsigned x; volatile LAS unsigned* st; };
__device__ __forceinline__ XcdBarrier xcd_barrier_post(unsigned* bar, volatile LAS unsigned* st) {
    XcdBarrier b; b.bar = bar; b.x = xb_xcc_id(); b.st = st;
    if (threadIdx.x == 0) (void)xb_add(&bar[XB_XCNT(b.x)], 1u);
    return b;
}
__device__ __forceinline__ void xcd_barrier_complete(unsigned* bar, unsigned x, unsigned& nloc, unsigned& nx) {
    const unsigned G = gridDim.x * gridDim.y * gridDim.z;
    unsigned sum, cnt, mine, sp = 0u;
    for (;;) {
        sum = 0u; cnt = 0u; mine = 0u;
#pragma unroll
        for (unsigned j = 0; j < 16; ++j) { const unsigned c = xb_ld(&bar[XB_XCNT(j)]); sum += c; cnt += (c > 0u) ? 1u : 0u; mine = (j == x) ? c : mine; }
        if (sum == G) break;
        __builtin_amdgcn_s_sleep(1);
        if ((++sp & 255u) == 0u) { if (xb_ld(&bar[XB_TMO])) break; if (sp > XB_SPIN_CAP) { atomicAdd(&bar[XB_TMO], 1u); break; } }
    }
    nloc = mine > 0u ? mine : 1u; nx = cnt > 0u ? cnt : 1u;
}
__device__ __forceinline__ void xcd_barrier(const XcdBarrier& b) {
    asm volatile("s_waitcnt vmcnt(0)" ::: "memory");
    __syncthreads();
    if (threadIdx.x == 0) {
        unsigned* bar = b.bar;
        __builtin_amdgcn_s_waitcnt(0);
        unsigned nloc = b.st[0], nx = b.st[1];
        if (nloc == 0u) { xcd_barrier_complete(bar, b.x, nloc, nx); b.st[0] = nloc; b.st[1] = nx; }
        const unsigned old = xb_add(&bar[XB_XSUB(b.x)], 1u);
        const unsigned gen = old / nloc;
        if (old + 1u == (gen + 1u) * nloc) {
            __builtin_amdgcn_fence(__ATOMIC_RELEASE, "agent");
            asm volatile("s_waitcnt vmcnt(0)" ::: "memory");
            const unsigned og = xb_add(&bar[XB_TOP], 1u);
            const unsigned tg = og / nx;
            if (og + 1u == (tg + 1u) * nx) xb_add(&bar[XB_TOPGEN], 1u);
            else XB_SPIN(xb_ld(&bar[XB_TOPGEN]) == tg, bar);
            __builtin_amdgcn_fence(__ATOMIC_ACQUIRE, "agent");
            xb_add(&bar[XB_XGEN(b.x)], 1u);
            asm volatile("s_waitcnt vmcnt(0)" ::: "memory");
        } else {
            XB_SPIN(xb_ld(&bar[XB_XGEN(b.x)]) == gen, bar);
            __builtin_amdgcn_fence(__ATOMIC_ACQUIRE, "agent");
            asm volatile("s_waitcnt vmcnt(0)" ::: "memory");
        }
    }
    __syncthreads();
}

constexpr int NPHASE = 12;
__global__ void __launch_bounds__(512, 2) fwd(Params P) {
    extern __shared__ __attribute__((aligned(16))) unsigned char shm[];
    cg::grid_group grid = cg::this_grid();
    const int lo = P.ph_lo, hi = P.ph_hi;
    const int tid = threadIdx.x, wave = tid >> 6;
    unsigned char* ws = P.ws;
    volatile LAS unsigned* bst = (volatile LAS unsigned*)((LAS unsigned char*)shm + BARST_OFF);
    if (tid == 0) { bst[0] = 0u; bst[1] = 0u; }
    __syncthreads();
    XcdBarrier xbar = xcd_barrier_post((unsigned*)(ws + O_BAR), bst);
    if (hi > 1000) grid.sync();
#ifndef REP
#define REP 0
#endif
#define NREP(k) (1 + ((REP >> (k)) & 1))
#ifndef PHMASK
#define PHMASK 0xFFF
#endif
#define IN(k) (((PHMASK >> (k)) & 1) && lo <= (k) && (k) < hi)
#define SEAM(k) do { if ((k) + 1 < hi) xcd_barrier(xbar); } while (0)
    if (IN(0)) for (int rep_ = 0; rep_ < NREP(0); ++rep_) { phase0(P, shm); SEAM(0); }
    if (IN(1)) for (int rep_ = 0; rep_ < NREP(1); ++rep_) { pg8::Gemm g{(const bf16_t*)(ws + O_XB), (const bf16_t*)(ws + O_WINT), MP, NPROJ, D}; pg8::StaticOrder S; S.init(MP, NPROJ, gridDim.x, blockIdx.x, GREP1);
        EpiIn E{(bf16_t*)(ws + O_PROJ)}; pg8::gemm_phase<EpiIn>((LAS unsigned char*)shm, g, S, E);
        convert_dynamic(P, shm, (unsigned*)(ws + O_BAR) + 8, 2304, 3840); SEAM(1); }
    if (IN(2)) for (int rep_ = 0; rep_ < NREP(2); ++rep_) {
        for (int r2 = 0; r2 < NREP(14); ++r2) for (int u = blockIdx.x; u < 272; u += gridDim.x) { if (u < 256) mlstm_local(P, shm, u >> 4, (u & 15) + 1); else mlstm_local(P, shm, u - 256, 0); }
        __syncthreads();
        for (int r2 = 0; r2 < NREP(15); ++r2) for (int id = blockIdx.x * 8 + wave; id < 4672; id += gridDim.x * 8) {
            if (id < 2048 && (id & 7) == 0) { mlstm_decode_wave(P, shm + wave * S5_WL, id >> 3); continue; }
            const int sidx = id < 2048 ? id - (id >> 3) - 1 : 1792 + (id - 2048);
            if (sidx < 3904) s5_unit<0>(P, shm + wave * S5_WL, sidx); else s5_unit<2>(P, shm + wave * S5_WL, sidx - 3904); }
        SEAM(2); }
    if (IN(3)) for (int rep_ = 0; rep_ < NREP(3); ++rep_) { for (int r2 = 0; r2 < NREP(12); ++r2) mlstm_prefix(P);
        for (int r2 = 0; r2 < NREP(13); ++r2) for (int id = blockIdx.x * 8 + wave; id < 4352; id += gridDim.x * 8) {
            if (id < 2048 && (id & 7) == 0) { mlstm_decode_wave(P, shm + wave * S5_WL, 256 + (id >> 3)); continue; }
            s5_unit<1>(P, shm + wave * S5_WL, id < 2048 ? id - (id >> 3) - 1 : 1792 + (id - 2048)); }
        SEAM(3); }
    if (IN(4)) for (int rep_ = 0; rep_ < NREP(4); ++rep_) { for (int u = blockIdx.x; u < 256; u += gridDim.x) mlstm_out(P, shm, u >> 4, (u & 15) + 1); if (!IN(5)) SEAM(4); }
    if (IN(5)) for (int rep_ = 0; rep_ < NREP(5); ++rep_) { pg8::Gemm g{(const bf16_t*)(ws + O_G), (const bf16_t*)(ws + O_WGLUT), MP, 1024, 1024}; pg8::StaticOrder S; S.init(MP, 1024, gridDim.x, blockIdx.x);
        EpiGlu E{(const bf16_t*)(ws + O_G), (bf16_t*)(ws + O_YA), P.in[19]}; pg8::gemm_phase<EpiGlu>((LAS unsigned char*)shm, g, S, E);
        convert_dynamic(P, shm, (unsigned*)(ws + O_BAR) + 16, 3840, 6272); SEAM(5); }
    if (IN(6)) for (int rep_ = 0; rep_ < NREP(6); ++rep_) { pg8::StaticOrder S; S.init(ROW_S, D, gridDim.x, blockIdx.x);
        { pg8::Gemm g{(const bf16_t*)(ws + O_YA), (const bf16_t*)(ws + O_WAT), ROW_S, D, 1024}; EpiUpA E{(const bf16_t*)(ws + O_PROJ), (bf16_t*)(ws + O_TMP)}; pg8::gemm_phase<EpiUpA>((LAS unsigned char*)shm, g, S, E); }
        { pg8::Gemm g{(const bf16_t*)(ws + O_YB), (const bf16_t*)(ws + O_WBT), ROW_S, D, 1024}; EpiUpB E{(const bf16_t*)(ws + O_PROJ), (const bf16_t*)(ws + O_TMP), (bf16_t*)(ws + O_MIX)}; pg8::gemm_phase<EpiUpB>((LAS unsigned char*)shm, g, S, E); }
        skinny_phase<0>(P, shm);
        SEAM(6); }
    if (IN(7)) for (int rep_ = 0; rep_ < NREP(7); ++rep_) { pg8::Gemm g{(const bf16_t*)(ws + O_MIX), (const bf16_t*)(ws + O_WOUTT), ROW_S, D, D}; pg8::StaticOrder S; S.init(ROW_S, D, gridDim.x, blockIdx.x);
        EpiRes E{P.in[0], P.in[1], nullptr, 0, (bf16_t*)(ws + O_R)}; pg8::gemm_phase<EpiRes>((LAS unsigned char*)shm, g, S, E); skinny_phase<1>(P, shm); SEAM(7); }
    if (IN(8)) for (int rep_ = 0; rep_ < NREP(8); ++rep_) { ln_pass(P, (const bf16_t*)(ws + O_R), P.in[24], P.in[25], 0); SEAM(8); }
    if (IN(9)) for (int rep_ = 0; rep_ < NREP(9); ++rep_) { pg8::Gemm g{(const bf16_t*)(ws + O_X1B), (const bf16_t*)(ws + O_WGUT), MP, 2 * DFF, D}; pg8::StaticOrder S; S.init(MP, 2 * DFF, gridDim.x, blockIdx.x);
        EpiGU E{(bf16_t*)(ws + O_HFF)}; pg8::gemm_phase<EpiGU>((LAS unsigned char*)shm, g, S, E);
        convert_dynamic(P, shm, (unsigned*)(ws + O_BAR) + 24, 6272, 7680); SEAM(9); }
    if (IN(10)) for (int rep_ = 0; rep_ < NREP(10); ++rep_) { pg8::Gemm g{(const bf16_t*)(ws + O_HFF), (const bf16_t*)(ws + O_WDT), ROW_S, D, DFF}; pg8::StaticOrder S; S.init(ROW_S, D, gridDim.x, blockIdx.x, GREP10);
        EpiRes E{nullptr, nullptr, (const bf16_t*)(ws + O_X1B), 1, (bf16_t*)(ws + O_R)}; pg8::gemm_phase<EpiRes>((LAS unsigned char*)shm, g, S, E); skinny_phase<2>(P, shm); SEAM(10); }
    if (IN(11)) for (int rep_ = 0; rep_ < NREP(11); ++rep_) { ln_pass(P, (const bf16_t*)(ws + O_R), P.in[29], P.in[30], 1); }
#undef IN
#undef SEAM
}

extern "C" void kernel_launch(void* const* d_in, const int* in_sizes, int n_in, void* d_out, int out_size, void* d_ws, size_t ws_size, hipStream_t stream) {
    static int grid = 0;
    if (grid == 0) {
        if (n_in != 31 || ws_size < O_END) { fprintf(stderr, "kernel_launch: unexpected sizes n_in %d out %d ws %zu (need %zu)\n", n_in, out_size, ws_size, (size_t)O_END); grid = -1; return; }
        int dev = 0, cus = 0, per_cu = 0;
        hipGetDevice(&dev); hipDeviceGetAttribute(&cus, hipDeviceAttributeMultiprocessorCount, dev);
        if (hipFuncSetAttribute((const void*)fwd, hipFuncAttributeMaxDynamicSharedMemorySize, LDS_BYTES) != hipSuccess) { fprintf(stderr, "kernel_launch: hipFuncSetAttribute failed\n"); grid = -1; return; }
        if (hipOccupancyMaxActiveBlocksPerMultiprocessor(&per_cu, (const void*)fwd, 512, LDS_BYTES) != hipSuccess || per_cu < 1) { fprintf(stderr, "kernel_launch: occupancy query says %d\n", per_cu); per_cu = 1; }
        (void)hipGetLastError();
        grid = cus * 1;
    }
    if (grid < 0) return;
    Params p{};
    for (int i = 0; i < 31; ++i) p.in[i] = (const float*)d_in[i];
    p.out = (float*)d_out; p.ws = (unsigned char*)d_ws;
    (void)hipMemsetAsync((unsigned char*)d_ws + O_BAR, 0, XCD_BAR_WORDS * 4, stream);
#if ONE_LAUNCH
    p.ph_lo = 0; p.ph_hi = NPHASE;
    void* args[] = {&p};
    hipError_t e = hipLaunchCooperativeKernel((const void*)fwd, dim3(grid), dim3(512), args, LDS_BYTES, stream);
    if (e != hipSuccess) fprintf(stderr, "cooperative launch failed: %s (grid %d)\n", hipGetErrorString(e), grid);
#else
    for (int ph = 0; ph < NPHASE; ++ph) { p.ph_lo = ph; p.ph_hi = ph + 1; hipLaunchKernelGGL(fwd, dim3(grid), dim3(512), LDS_BYTES, stream, p); }
#endif
}
```
